# Optimizing an MI355X kernel written in HIP

```python
import jax, jax.numpy as jnp
from jax import lax
import numpy as np

D_MODEL = 1024
BATCH = 4
SEQ = 4096
DEPTH = 2
DEC_BATCH = 128
DEC_SEQ = 4
PAST_LEN = 2048
PAGE_SIZE = 128

N_MIXERS = 2
N_A_LAYERS = (DEPTH + 1) // 2
N_B_LAYERS = DEPTH // 2
N_HEADS = 8
HEAD_DIM = D_MODEL // N_HEADS
N_KV_HEADS = 2
GROUP = N_HEADS // N_KV_HEADS
IDX_HEADS = 8
IDX_DIM = 64
TOPK_MAX = 256
Q_BLOCK = 128
POOL_WINDOWS = (2, 4, 8, 16)
N_POOL_GROUPS = len(POOL_WINDOWS)
POOL_GROUP_DIM = D_MODEL // N_POOL_GROUPS
POOL_STATE = max(POOL_WINDOWS) - 1
D_FF = 4 * D_MODEL
RMS_EPS = 1e-6
Q_W = N_HEADS * HEAD_DIM
KV_W = N_KV_HEADS * HEAD_DIM
QI_W = IDX_HEADS * IDX_DIM
PROJ_SPLITS = (Q_W, Q_W + KV_W, Q_W + 2 * KV_W, Q_W + 2 * KV_W + QI_W, Q_W + 2 * KV_W + QI_W + IDX_DIM)
D_PROJ = Q_W + 2 * KV_W + QI_W + IDX_DIM + IDX_HEADS

kernel_name = 'dsa_pool_hybrid_step'


def rmsnorm(x, g):
    xf = x.astype(jnp.float32)
    y = xf * lax.rsqrt(jnp.mean(xf * xf, axis=-1, keepdims=True) + RMS_EPS)
    return (y * g.astype(jnp.float32)).astype(x.dtype)


def modulate(h, shift, scale):
    return h * (1 + scale[:, None, :]) + shift[:, None, :]


def dsa_block(qb, qib, wib, posb, keys, vals, kidx, k_sel):
    n, qblk = qb.shape[0], qb.shape[1]
    L = keys.shape[1]
    logits = jnp.einsum('nqhd,nsd->nqhs', qib.astype(jnp.float32), kidx.astype(jnp.float32)) * (IDX_DIM ** -0.5)
    score = jnp.einsum('nqhs,nqh->nqs', jax.nn.relu(logits), wib.astype(jnp.float32)) * (IDX_HEADS ** -0.5)
    causal = jnp.arange(L)[None, :] <= posb[:, None]
    score = jnp.where(causal[None], score, -jnp.inf)
    _, idx = lax.top_k(score, k_sel)
    valid = idx <= posb[None, :, None]
    k_g = jax.vmap(lambda a, i: a[i])(keys, idx)
    v_g = jax.vmap(lambda a, i: a[i])(vals, idx)
    s = jnp.einsum('nqgrd,nqkgd->nqgrk', qb.astype(jnp.float32), k_g.astype(jnp.float32)) * (HEAD_DIM ** -0.5)
    s = jnp.where(valid[:, :, None, None, :], s, -jnp.inf)
    p = jax.nn.softmax(s, axis=-1)
    o = jnp.einsum('nqgrk,nqkgd->nqgrd', p, v_g.astype(jnp.float32))
    return o.reshape(n, qblk, N_HEADS * HEAD_DIM).astype(qb.dtype)


def dsa_mixer(h, w_in, w_o, past_k, past_v, past_kidx, pos0):
    n, t, _ = h.shape
    proj = h @ w_in
    q, k, v, qi, ki, wi = jnp.split(proj, PROJ_SPLITS, axis=-1)
    q = q.reshape(n, t, N_KV_HEADS, GROUP, HEAD_DIM)
    k = k.reshape(n, t, N_KV_HEADS, HEAD_DIM)
    v = v.reshape(n, t, N_KV_HEADS, HEAD_DIM)
    qi = qi.reshape(n, t, IDX_HEADS, IDX_DIM)
    if past_k is None:
        keys, vals, kidx = k, v, ki
    else:
        keys = jnp.concatenate([past_k.astype(k.dtype), k], axis=1)
        vals = jnp.concatenate([past_v.astype(v.dtype), v], axis=1)
        kidx = jnp.concatenate([past_kidx.astype(ki.dtype), ki], axis=1)
    L = keys.shape[1]
    k_sel = min(TOPK_MAX, L // 4)
    qb = min(Q_BLOCK, t)
    nblk = t // qb

    def to_blocks(a):
        return jnp.moveaxis(a.reshape((n, nblk, qb) + a.shape[2:]), 1, 0)

    pos = pos0 + jnp.arange(t)
    xs = (to_blocks(q), to_blocks(qi), to_blocks(wi), pos.reshape(nblk, qb))
    o = lax.map(lambda a: dsa_block(a[0], a[1], a[2], a[3], keys, vals, kidx, k_sel), xs)
    o = jnp.moveaxis(o, 0, 1).reshape(n, t, N_HEADS * HEAD_DIM)
    return o @ w_o, (k, v, ki)


def pool_mixer(h, prev, pos0, w_grp, scale):
    n, t, d = h.shape
    ext = jnp.concatenate([prev.astype(h.dtype), h], axis=1)
    cs = jnp.pad(jnp.cumsum(ext.astype(jnp.float32), axis=1), ((0, 0), (1, 0), (0, 0)))
    P = POOL_STATE
    end = cs[:, P + 1:P + 1 + t]
    pos = pos0 + jnp.arange(t)
    parts = []
    for g, w in enumerate(POOL_WINDOWS):
        lo, hi = g * POOL_GROUP_DIM, (g + 1) * POOL_GROUP_DIM
        win = end[..., lo:hi] - cs[:, P + 1 - w:P + 1 - w + t, lo:hi]
        cnt = jnp.minimum(w, pos + 1).astype(jnp.float32)[None, :, None]
        parts.append(win / cnt - h[..., lo:hi].astype(jnp.float32))
    pooled = jnp.stack(parts, axis=2)
    out = jnp.einsum('ntgc,gcd->ntgd', pooled, w_grp.astype(jnp.float32)).reshape(n, t, d)
    out = out * scale.astype(jnp.float32)
    return out.astype(h.dtype), ext[:, -P:]


def sq_relu_mlp(h, w_up, w_down):
    return jnp.square(jax.nn.relu(h @ w_up)) @ w_down


def setup_inputs(seed: int = 0) -> dict:
    key = jax.random.key(seed)
    ks = jax.random.split(key, 24)
    f32 = jnp.float32
    n_pages = PAST_LEN // PAGE_SIZE
    n_used = DEC_BATCH * n_pages
    n_pool = n_used + n_used // 4

    def nrm(k, shape, s):
        return jax.random.normal(k, shape, f32) * s

    page_table = jax.random.permutation(ks[6], n_pool)[:n_used].reshape(DEC_BATCH, n_pages).astype(jnp.int32)
    return {
        'x_prompt': nrm(ks[0], (BATCH, SEQ, D_MODEL), 1.0),
        'x_sample': nrm(ks[1], (DEC_BATCH, DEC_SEQ, D_MODEL), 1.0),
        'cache_k': nrm(ks[2], (N_A_LAYERS, n_pool, PAGE_SIZE, N_KV_HEADS, HEAD_DIM), 1.0),
        'cache_v': nrm(ks[3], (N_A_LAYERS, n_pool, PAGE_SIZE, N_KV_HEADS, HEAD_DIM), 1.0),
        'cache_kidx': nrm(ks[4], (N_A_LAYERS, n_pool, PAGE_SIZE, IDX_DIM), 1.0),
        'state_pool': nrm(ks[5], (N_B_LAYERS, DEC_BATCH, POOL_STATE, D_MODEL), 1.0),
        'page_table': page_table,
        'c_prompt': nrm(ks[7], (BATCH, D_MODEL), 1.0),
        'c_sample': nrm(ks[8], (DEC_BATCH, D_MODEL), 1.0),
        'norm_mix_g': 1.0 + nrm(ks[9], (DEPTH, D_MODEL), 0.05),
        'norm_ffn_g': 1.0 + nrm(ks[10], (DEPTH, D_MODEL), 0.05),
        'w_mod': nrm(ks[11], (DEPTH, D_MODEL, 6 * D_MODEL), 0.5 * D_MODEL ** -0.5),
        'b_mod': nrm(ks[12], (DEPTH, 6 * D_MODEL), 0.02),
        'dsa_w_in': nrm(ks[13], (N_A_LAYERS, D_MODEL, D_PROJ), D_MODEL ** -0.5),
        'dsa_w_o': nrm(ks[14], (N_A_LAYERS, N_HEADS * HEAD_DIM, D_MODEL), (N_HEADS * HEAD_DIM) ** -0.5),
        'pool_w': nrm(ks[15], (N_B_LAYERS, N_POOL_GROUPS, POOL_GROUP_DIM, POOL_GROUP_DIM), POOL_GROUP_DIM ** -0.5),
        'pool_scale': 1.0 + nrm(ks[16], (N_B_LAYERS, D_MODEL), 0.1),
        'w_up': nrm(ks[17], (DEPTH, D_MODEL, D_FF), D_MODEL ** -0.5),
        'w_down': nrm(ks[18], (DEPTH, D_FF, D_MODEL), D_FF ** -0.5),
        'final_norm_g': 1.0 + nrm(ks[19], (D_MODEL,), 0.05),
    }


def reference(x_prompt, x_sample, cache_k, cache_v, cache_kidx, state_pool, page_table, c_prompt, c_sample,
              norm_mix_g, norm_ffn_g, w_mod, b_mod, dsa_w_in, dsa_w_o, pool_w, pool_scale, w_up, w_down,
              final_norm_g):
    def run(x, c, is_sample):
        n = x.shape[0]
        pos0 = PAST_LEN if is_sample else 0
        mod_in = jax.nn.silu(c)
        new_k, new_v, new_ki, new_pool = [], [], [], []
        for i in range(DEPTH):
            mod = mod_in @ w_mod[i] + b_mod[i]
            sh1, sc1, g1, sh2, sc2, g2 = jnp.split(mod, 6, axis=-1)
            h = modulate(rmsnorm(x, norm_mix_g[i]), sh1, sc1)
            j = i // N_MIXERS
            if i % N_MIXERS == 0:
                if is_sample:
                    pk = cache_k[j][page_table].reshape(n, -1, N_KV_HEADS, HEAD_DIM)
                    pv = cache_v[j][page_table].reshape(n, -1, N_KV_HEADS, HEAD_DIM)
                    pki = cache_kidx[j][page_table].reshape(n, -1, IDX_DIM)
                else:
                    pk, pv, pki = None, None, None
                m, (k_rows, v_rows, ki_rows) = dsa_mixer(h, dsa_w_in[j], dsa_w_o[j], pk, pv, pki, pos0)
                new_k.append(k_rows)
                new_v.append(v_rows)
                new_ki.append(ki_rows)
            else:
                prev = state_pool[j] if is_sample else jnp.zeros((n, POOL_STATE, D_MODEL), h.dtype)
                m, st = pool_mixer(h, prev, pos0, pool_w[j], pool_scale[j])
                new_pool.append(st)
            x = x + g1[:, None, :] * m
            h = modulate(rmsnorm(x, norm_ffn_g[i]), sh2, sc2)
            x = x + g2[:, None, :] * sq_relu_mlp(h, w_up[i], w_down[i])
        y = rmsnorm(x, final_norm_g)
        return y, jnp.stack(new_k), jnp.stack(new_v), jnp.stack(new_ki), jnp.stack(new_pool)

    y_prompt, k_p, v_p, ki_p, pool_p = run(x_prompt, c_prompt, False)
    y_sample, k_s, v_s, ki_s, pool_s = run(x_sample, c_sample, True)
    return (y_prompt, y_sample, k_p, v_p, ki_p, pool_p, k_s, v_s, ki_s, pool_s)
```

```cpp
#include <hip/hip_runtime.h>
#include <hip/hip_cooperative_groups.h>
#include <cstdio>
#include <cstdint>
namespace cg = cooperative_groups;

#define LAS __attribute__((address_space(3)))
typedef unsigned short bf16_t;
typedef short bf16x8 __attribute__((ext_vector_type(8)));
typedef short s16x4 __attribute__((ext_vector_type(4)));
typedef float f32x2 __attribute__((ext_vector_type(2)));
typedef float f32x4 __attribute__((ext_vector_type(4)));
typedef float f32x16 __attribute__((ext_vector_type(16)));
typedef unsigned u32x2 __attribute__((ext_vector_type(2)));
typedef unsigned u32x4 __attribute__((ext_vector_type(4)));
typedef __bf16 bf16x2_t __attribute__((ext_vector_type(2)));

constexpr int D = 1024, NBATCH = 4, SEQ = 4096, MP = NBATCH * SEQ, DECB = 128, DECS = 4, MS = DECB * DECS, MT = MP + MS;
constexpr int PAST = 2048, PAGE = 128, PAGES_PER_SEQ = 16;
constexpr int NH = 8, HD = 128, NKV = 2, KVW = NKV * HD, IH = 8, IDD = 64, QIW = IH * IDD, TOPK = 256;
constexpr int DFF = 4096, DPROJ = 2120, NPROJ = 2304, NMOD = 6 * D, NBROW = NBATCH + DECB;
constexpr int POOLST = 15;
constexpr float RMS_EPS = 1e-6f;
constexpr size_t O_YP = 0, O_YS = O_YP + (size_t)MP * D, O_KP = O_YS + (size_t)MS * D, O_VP = O_KP + (size_t)MP * KVW, O_KIP = O_VP + (size_t)MP * KVW,
                 O_POOLP = O_KIP + (size_t)MP * IDD, O_KS = O_POOLP + (size_t)NBATCH * POOLST * D, O_VS = O_KS + (size_t)MS * KVW, O_KIS = O_VS + (size_t)MS * KVW,
                 O_POOLS = O_KIS + (size_t)MS * IDD, O_END = O_POOLS + (size_t)DECB * POOLST * D;
constexpr size_t MiB = 1u << 20;
constexpr size_t WS_CTL = 0, CTL_ZERO_BYTES = 1 * MiB, WS_MOD = 1 * MiB, WS_SILU = 8 * MiB, WS_WIN = 9 * MiB, WS_WO = 14 * MiB, WS_WPOOL = 16 * MiB, WS_WUP = 17 * MiB,
                 WS_WDN = 33 * MiB, WS_HB = 49 * MiB, WS_QB = 82 * MiB, WS_KB = 115 * MiB, WS_VB = 124 * MiB, WS_QIB = 133 * MiB, WS_KIB = 150 * MiB, WS_WIF = 153 * MiB,
                 WS_OB = 154 * MiB, WS_X = 187 * MiB, WS_UB = 253 * MiB, WS_END = 385 * MiB;
constexpr int CW_BAR = 4096;
constexpr int RING_BYTES = 131072, IDXL_OFF = RING_BYTES, MISC_OFF = IDXL_OFF + 4096, LDS_BYTES = 147456;
constexpr int NWAVES = 8, NTHREADS = 512;

__device__ __forceinline__ unsigned pk2(float lo, float hi) { f32x2 v = {lo, hi}; bf16x2_t b = __builtin_convertvector(v, bf16x2_t); return __builtin_bit_cast(unsigned, b); }
__device__ __forceinline__ float bflo(unsigned u) { return __uint_as_float(u << 16); }
__device__ __forceinline__ float bfhi(unsigned u) { return __uint_as_float(u & 0xffff0000u); }
__device__ __forceinline__ bf16x8 pack8(f32x4 a, f32x4 b) { u32x4 w; w.x = pk2(a[0], a[1]); w.y = pk2(a[2], a[3]); w.z = pk2(b[0], b[1]); w.w = pk2(b[2], b[3]); return __builtin_bit_cast(bf16x8, w); }
#define LDS_WAIT() asm volatile("s_waitcnt lgkmcnt(0)" ::: "memory")
#define VM_WAIT() asm volatile("s_waitcnt vmcnt(0)" ::: "memory")

namespace pg8 {
constexpr int BM = 256, BK = 64, HALF = 128, HTB = HALF * BK * 2, STAGE_BYTES = 8 * HTB, NXCD = 8, WGM = 8;
__host__ __device__ __forceinline__ int lds_byte(int r, int c) { const int st = (r >> 4) * 2 + (c >> 5), rr = r & 15, cc = c & 31, ob = rr * 64 + cc * 2; return st * 1024 + (ob ^ (((ob >> 9) & 1) << 5)); }
__host__ __device__ __forceinline__ void stage_rc(int b, int& R, int& C) { const int st = b / 1024, sb = b % 1024, swz = sb ^ (((sb >> 9) & 1) << 5); R = (st >> 1) * 16 + swz / 64; C = (st & 1) * 32 + (swz % 64) / 2; }
__host__ __device__ __forceinline__ int perm32(int rho) { const int n = rho >> 4, i = rho & 15; return 8 * (i >> 2) + 4 * n + (i & 3); }
struct Unit { int pm, pn; };
struct Gemm { const bf16_t* A; const bf16_t* Bt; int M, N, K, lda, ldb, acol; };
struct StaticOrder {
    int nM, nN, nwg, G, c;
    __device__ void init(int M, int N, int G_, int c_) { nM = M / BM; nN = N / BM; nwg = nM * nN; G = G_; c = c_; }
    __device__ bool next(int i, Unit& u) const {
        const long L = (long)i * G + c; if (L >= nwg) return false;
        int wgid = (int)L; { const int q = nwg / NXCD, r = nwg % NXCD, xcd = wgid % NXCD, off = wgid / NXCD; wgid = (xcd < r ? xcd * (q + 1) : r * (q + 1) + (xcd - r) * q) + off; }
        const int nig = WGM * nN, gid = wgid / nig, fm = gid * WGM, gsz = (nM - fm) < WGM ? (nM - fm) : WGM;
        u.pm = fm + ((wgid % nig) % gsz); u.pn = (wgid % nig) / gsz; return true;
    }
    __device__ __forceinline__ void a_ready(const Unit&) const {}
    __device__ __forceinline__ void done(const Unit&) const {}
};

template <class Epi, class Sched, bool ALIGN_EPI>
__device__ __forceinline__ void gemm_phase(LAS unsigned char* lds, const Gemm g, const Sched& S, const Epi& E) {
    int tid_ = threadIdx.x; asm volatile("" : "+v"(tid_));
    const int tid = tid_, wid = __builtin_amdgcn_readfirstlane(tid >> 6), lane = tid & 63, wr = wid >> 2, wc = wid & 3, fr = lane & 15, fq = lane >> 4;
    const int K = g.K, nt = K / BK;
    unsigned voffA[2], voffB[2];
#pragma unroll
    for (int i = 0; i < 2; ++i) { int R, C; stage_rc(tid * 16 + i * 8192, R, C); const int Rb = Epi::PERM ? ((R & ~31) + perm32(R & 31)) : R;
        voffA[i] = (unsigned)(R * g.lda + C) * 2u; voffB[i] = (unsigned)(Rb * g.ldb + C) * 2u; }
    const size_t kstep = (size_t)(BK * 2);
    const size_t hstepA = (size_t)HALF * g.lda * 2, hstepB = (size_t)HALF * g.ldb * 2;
    const size_t tstepA = 2 * hstepA, tstepB = 2 * hstepB;
    const unsigned ldsw = (unsigned)wid * 1024u;
    const int aoff = lds_byte(wr * 64 + fr, fq * 8), boff = lds_byte(wc * 32 + fr, fq * 8);
#define PG8_SA(b, h) (((b) * 2 + (h)) * HTB)
#define PG8_SB(b, h) ((4 + (b) * 2 + (h)) * HTB)
#define PG8_STAGE(bufoff, gbase, voff) do { _Pragma("unroll") for (int _i = 0; _i < 2; ++_i) \
        __builtin_amdgcn_global_load_lds((const unsigned*)((const char*)(gbase) + (voff)[_i]), (LAS unsigned*)(lds + (bufoff) + ldsw + _i * 8192), 16, 0, 0); } while (0)
#define PG8_LDA(dst, b, h) do { _Pragma("unroll") for (int m = 0; m < 4; ++m) _Pragma("unroll") for (int k = 0; k < 2; ++k) dst[m][k] = *(const LAS bf16x8*)(lds + PG8_SA(b, h) + aoff + m * 2048 + k * 1024); } while (0)
#define PG8_LDB(dst, b, h) do { _Pragma("unroll") for (int n = 0; n < 2; ++n) _Pragma("unroll") for (int k = 0; k < 2; ++k) dst[n][k] = *(const LAS bf16x8*)(lds + PG8_SB(b, h) + boff + n * 2048 + k * 1024); } while (0)
#define PG8_MMA(ai, bj, At, Bt) do { __builtin_amdgcn_s_setprio(1); _Pragma("unroll") for (int m = 0; m < 4; ++m) _Pragma("unroll") for (int n = 0; n < 2; ++n) _Pragma("unroll") for (int k = 0; k < 2; ++k) \
        acc[ai][bj][m][n] = __builtin_amdgcn_mfma_f32_16x16x32_bf16(Bt[n][k], At[m][k], acc[ai][bj][m][n], 0, 0, 0); __builtin_amdgcn_s_setprio(0); } while (0)
#define PG8_WAIT_V(n) asm volatile("s_waitcnt vmcnt(" #n ")" ::: "memory")
#define PG8_WAIT_L(n) asm volatile("s_waitcnt lgkmcnt(" #n ")" ::: "memory")
#define PG8_BAR __builtin_amdgcn_s_barrier()
#define PG8_SCHED __builtin_amdgcn_sched_barrier(0)
#define PG8_UA(u) ((const char*)g.A + (size_t)(u).pm * tstepA + (size_t)(u).pn * (size_t)g.acol * 2)
#define PG8_UB(u) ((const char*)g.Bt + (size_t)(u).pn * tstepB)
    Unit cur, nxt; int ui = 0;
    if (!S.next(0, cur)) return;
    f32x4 acc[2][2][4][2];
#pragma unroll
    for (int a = 0; a < 2; ++a)
#pragma unroll
        for (int b = 0; b < 2; ++b)
#pragma unroll
            for (int m = 0; m < 4; ++m)
#pragma unroll
                for (int n = 0; n < 2; ++n) acc[a][b][m][n] = (f32x4){0.f, 0.f, 0.f, 0.f};
    bf16x8 At[4][2], B0[2][2], B1[2][2];
    const char* cA = PG8_UA(cur); const char* cB = PG8_UB(cur);
    S.a_ready(cur);
    PG8_STAGE(PG8_SB(0, 0), cB, voffB); PG8_STAGE(PG8_SB(0, 1), cB + hstepB, voffB); PG8_STAGE(PG8_SA(0, 0), cA, voffA); PG8_STAGE(PG8_SA(0, 1), cA + hstepA, voffA);
    if (wr == 1) PG8_BAR;
    PG8_WAIT_V(2); PG8_BAR;
    PG8_STAGE(PG8_SB(1, 0), cB + kstep, voffB); PG8_STAGE(PG8_SA(1, 0), cA + kstep, voffA); PG8_STAGE(PG8_SB(1, 1), cB + hstepB + kstep, voffB);
    PG8_WAIT_V(6); PG8_BAR;
    for (;;) {
        const bool has_next = S.next(ui + 1, nxt);
        const char* nA = has_next ? PG8_UA(nxt) : cA; const char* nB = has_next ? PG8_UB(nxt) : cB;
        for (int t = 0; t < nt; t += 2) {
            const bool last = (t == nt - 2);
            const char* a1 = cA + (size_t)(t + 1) * kstep;
            const char* a2 = last ? nA : cA + (size_t)(t + 2) * kstep; const char* b2 = last ? nB : cB + (size_t)(t + 2) * kstep;
            const char* a3 = a2 + kstep; const char* b3 = b2 + kstep;
            if (last && has_next) S.a_ready(nxt);
            PG8_LDB(B0, 0, 0); PG8_LDB(B1, 0, 1); PG8_SCHED; PG8_LDA(At, 0, 0); PG8_STAGE(PG8_SA(1, 1), a1 + hstepA, voffA);
            PG8_WAIT_V(8); PG8_WAIT_L(0); PG8_BAR; PG8_MMA(0, 0, At, B0); PG8_MMA(0, 1, At, B1); PG8_BAR; PG8_SCHED;
            PG8_LDA(At, 0, 1); PG8_STAGE(PG8_SB(0, 0), b2, voffB); PG8_STAGE(PG8_SB(0, 1), b2 + hstepB, voffB); PG8_STAGE(PG8_SA(0, 0), a2, voffA);
            PG8_WAIT_V(8); PG8_WAIT_L(0); PG8_BAR; PG8_MMA(1, 0, At, B0); PG8_MMA(1, 1, At, B1); PG8_BAR; PG8_SCHED;
            PG8_LDB(B0, 1, 0); PG8_LDB(B1, 1, 1); PG8_SCHED; PG8_LDA(At, 1, 0); PG8_STAGE(PG8_SA(0, 1), a2 + hstepA, voffA);
            PG8_WAIT_V(8); PG8_WAIT_L(0); PG8_BAR; PG8_MMA(0, 0, At, B0); PG8_MMA(0, 1, At, B1); PG8_BAR; PG8_SCHED;
            PG8_LDA(At, 1, 1); PG8_STAGE(PG8_SB(1, 0), b3, voffB); PG8_STAGE(PG8_SB(1, 1), b3 + hstepB, voffB); PG8_STAGE(PG8_SA(1, 0), a3, voffA);
            PG8_WAIT_V(8); PG8_WAIT_L(0); PG8_BAR; PG8_MMA(1, 0, At, B0); PG8_MMA(1, 1, At, B1); PG8_BAR; PG8_SCHED;
        }
        if constexpr (ALIGN_EPI) { if (wr == 0) PG8_BAR; }
        E(acc, cur, wr, wc, fr, fq); S.done(cur);
        if (!has_next) break;
#pragma unroll
        for (int a = 0; a < 2; ++a)
#pragma unroll
            for (int b = 0; b < 2; ++b)
#pragma unroll
                for (int m = 0; m < 4; ++m)
#pragma unroll
                    for (int n = 0; n < 2; ++n) acc[a][b][m][n] = (f32x4){0.f, 0.f, 0.f, 0.f};
        cur = nxt; cA = nA; cB = nB; ++ui;
        if constexpr (ALIGN_EPI) { if (wr == 1) PG8_BAR; }
    }
    PG8_WAIT_V(0);
    if constexpr (!ALIGN_EPI) { if (wr == 0) PG8_BAR; }
    PG8_BAR;
#undef PG8_SA
#undef PG8_SB
#undef PG8_STAGE
#undef PG8_LDA
#undef PG8_LDB
#undef PG8_MMA
#undef PG8_WAIT_V
#undef PG8_WAIT_L
#undef PG8_BAR
#undef PG8_SCHED
#undef PG8_UA
#undef PG8_UB
}
}

#define XB_TMO      128
#define XB_XCNT(j)  (256  + 64 * (j))
#define XB_XSUB(j)  (1280 + 64 * (j))
#define XB_XGEN(j)  (2304 + 64 * (j))
#define XB_TOP      3328
#define XB_TOPGEN   3392
#define XCD_BAR_WORDS 3456
#define XB_SPIN_CAP (1u << 18)
__device__ __forceinline__ unsigned xb_ld(unsigned* p)              { return __hip_atomic_load(p, __ATOMIC_RELAXED, __HIP_MEMORY_SCOPE_AGENT); }
__device__ __forceinline__ unsigned xb_add(unsigned* p, unsigned v) { return __hip_atomic_fetch_add(p, v, __ATOMIC_RELAXED, __HIP_MEMORY_SCOPE_AGENT); }
__device__ __forceinline__ unsigned xb_xcc_id() { return (unsigned)__builtin_amdgcn_s_getreg((3 << 11) | 20) & 0xFu; }
#define XB_SPIN(cond, bar) do { unsigned _sp = 0; while (cond) { __builtin_amdgcn_s_sleep(1); \
    if ((++_sp & 255u) == 0u) { if (xb_ld(&(bar)[XB_TMO])) break; if (_sp > XB_SPIN_CAP) { atomicAdd(&(bar)[XB_TMO], 1u); break; } } } } while (0)
struct XcdBarrier { unsigned* bar; unsigned x; volatile LAS unsigned* st; };
__device__ __forceinline__ XcdBarrier xcd_barrier_post(unsigned* bar, volatile LAS unsigned* st) {
    XcdBarrier b; b.bar = bar; b.x = xb_xcc_id(); b.st = st;
    if (threadIdx.x == 0) (void)xb_add(&bar[XB_XCNT(b.x)], 1u);
    return b;
}
__device__ __forceinline__ void xcd_barrier_complete(unsigned* bar, unsigned x, unsigned& nloc, unsigned& nx) {
    const unsigned G = gridDim.x * gridDim.y * gridDim.z;
    unsigned sum, cnt, mine, sp = 0u;
    for (;;) {
        sum = 0u; cnt = 0u; mine = 0u;
#pragma unroll
        for (unsigned j = 0; j < 16; ++j) { const unsigned c = xb_ld(&bar[XB_XCNT(j)]); sum += c; cnt += (c > 0u) ? 1u : 0u; mine = (j == x) ? c : mine; }
        if (sum == G) break;
        __builtin_amdgcn_s_sleep(1);
        if ((++sp & 255u) == 0u) { if (xb_ld(&bar[XB_TMO])) break; if (sp > XB_SPIN_CAP) { atomicAdd(&bar[XB_TMO], 1u); break; } }
    }
    nloc = mine > 0u ? mine : 1u; nx = cnt > 0u ? cnt : 1u;
}
__device__ __forceinline__ void xcd_barrier(const XcdBarrier& b) {
    asm volatile("s_waitcnt vmcnt(0)" ::: "memory");
    __syncthreads();
    if (threadIdx.x == 0) {
        unsigned* bar = b.bar;
        __builtin_amdgcn_s_waitcnt(0);
        unsigned nloc = b.st[0], nx = b.st[1];
        if (nloc == 0u) { xcd_barrier_complete(bar, b.x, nloc, nx); b.st[0] = nloc; b.st[1] = nx; }
        const unsigned old = xb_add(&bar[XB_XSUB(b.x)], 1u);
        const unsigned gen = old / nloc;
        if (old + 1u == (gen + 1u) * nloc) {
            __builtin_amdgcn_fence(__ATOMIC_RELEASE, "agent");
            asm volatile("s_waitcnt vmcnt(0)" ::: "memory");
            const unsigned og = xb_add(&bar[XB_TOP], 1u);
            const unsigned tg = og / nx;
            if (og + 1u == (tg + 1u) * nx) xb_add(&bar[XB_TOPGEN], 1u);
            else XB_SPIN(xb_ld(&bar[XB_TOPGEN]) == tg, bar);
            __builtin_amdgcn_fence(__ATOMIC_ACQUIRE, "agent");
            xb_add(&bar[XB_XGEN(b.x)], 1u);
            asm volatile("s_waitcnt vmcnt(0)" ::: "memory");
        } else {
            XB_SPIN(xb_ld(&bar[XB_XGEN(b.x)]) == gen, bar);
            __builtin_amdgcn_fence(__ATOMIC_ACQUIRE, "agent");
            asm volatile("s_waitcnt vmcnt(0)" ::: "memory");
        }
    }
    __syncthreads();
}

struct Params { const float* in[20]; float* out; unsigned char* ws; };
struct Frame {
    LAS unsigned char* lds;
    int tid, lane, wave, G, bid;
    const float *x_p, *x_s, *cache_k, *cache_v, *cache_ki, *state_pool, *c_p, *c_s, *g_mix, *g_ffn, *w_mod, *b_mod, *w_in, *w_o, *pool_w, *pool_scale, *w_up, *w_down, *g_final;
    const int* page_table;
    float* out; unsigned char* ws;
    float* MOD; bf16_t *SILU, *WIN, *WO, *WPOOL, *WUP, *WDN, *HB, *QB, *KB, *VB, *QIB, *KIB, *OB, *UB; float *WIF, *X;
};
__device__ __forceinline__ int brow_of(int r) { return r < MP ? (r >> 12) : NBATCH + ((r - MP) >> 2); }

struct EpiProj {
    static constexpr bool PERM = true;
    bf16_t *QB, *KB, *VB, *QIB, *KIB; float* WIF; float* out;
    __device__ __forceinline__ void operator()(const f32x4 (&acc)[2][2][4][2], const pg8::Unit& u, int wr, int wc, int fr, int fq) const {
        const int pn = u.pn;
#pragma unroll
        for (int ai = 0; ai < 2; ++ai)
#pragma unroll
            for (int m = 0; m < 4; ++m) {
                const int row = u.pm * 256 + ai * 128 + wr * 64 + m * 16 + fr;
#pragma unroll
                for (int bj = 0; bj < 2; ++bj) {
                    const int cl = bj * 128 + wc * 32 + 8 * fq;
                    const f32x4 v0 = acc[ai][bj][m][0], v1 = acc[ai][bj][m][1];
                    const bf16x8 pk = pack8(v0, v1);
                    if (pn < 4) { *(bf16x8*)(QB + (size_t)row * D + pn * 256 + cl) = pk; }
                    else if (pn == 4 || pn == 5) {
                        bf16_t* B = pn == 4 ? KB : VB; *(bf16x8*)(B + (size_t)row * KVW + cl) = pk;
                        float* o = out + (row < MP ? (pn == 4 ? O_KP : O_VP) + (size_t)row * KVW : (pn == 4 ? O_KS : O_VS) + (size_t)(row - MP) * KVW) + cl;
                        *(f32x4*)o = v0; *(f32x4*)(o + 4) = v1;
                    } else if (pn < 8) { *(bf16x8*)(QIB + (size_t)row * QIW + (pn - 6) * 256 + cl) = pk; }
                    else {
                        if (cl < 64) { *(bf16x8*)(KIB + (size_t)row * IDD + cl) = pk;
                            float* o = out + (row < MP ? O_KIP + (size_t)row * IDD : O_KIS + (size_t)(row - MP) * IDD) + cl; *(f32x4*)o = v0; *(f32x4*)(o + 4) = v1; }
                        else if (cl == 64) { float* o = WIF + (size_t)row * 8; *(f32x4*)o = v0; *(f32x4*)(o + 4) = v1; }
                    }
                }
            }
    }
};
struct EpiUp {
    static constexpr bool PERM = true;
    bf16_t* UB;
    __device__ __forceinline__ void operator()(const f32x4 (&acc)[2][2][4][2], const pg8::Unit& u, int wr, int wc, int fr, int fq) const {
#pragma unroll
        for (int ai = 0; ai < 2; ++ai)
#pragma unroll
            for (int m = 0; m < 4; ++m) {
                const int row = u.pm * 256 + ai * 128 + wr * 64 + m * 16 + fr;
#pragma unroll
                for (int bj = 0; bj < 2; ++bj) {
                    const int cl = u.pn * 256 + bj * 128 + wc * 32 + 8 * fq;
                    f32x4 v0 = acc[ai][bj][m][0], v1 = acc[ai][bj][m][1];
#pragma unroll
                    for (int j = 0; j < 4; ++j) { const float a = fmaxf(v0[j], 0.f), b = fmaxf(v1[j], 0.f); v0[j] = a * a; v1[j] = b * b; }
                    *(bf16x8*)(UB + (size_t)row * DFF + cl) = pack8(v0, v1);
                }
            }
    }
};
struct EpiRes {
    static constexpr bool PERM = false;
    const float *xin_p, *xin_s;
    float* X; const float* gate;
    const float* cscale;
    __device__ __forceinline__ void operator()(const f32x4 (&acc)[2][2][4][2], const pg8::Unit& u, int wr, int wc, int fr, int fq) const {
#pragma unroll
        for (int ai = 0; ai < 2; ++ai)
#pragma unroll
            for (int m = 0; m < 4; ++m) {
                const int row = u.pm * 256 + ai * 128 + wr * 64 + m * 16 + fr;
                const float* xi = row < MP ? xin_p + (size_t)row * D : xin_s + (size_t)(row - MP) * D;
                const float* gr = gate + (size_t)brow_of(row) * NMOD;
#pragma unroll
                for (int bj = 0; bj < 2; ++bj)
#pragma unroll
                    for (int n = 0; n < 2; ++n) {
                        const int c = u.pn * 256 + bj * 128 + wc * 32 + 16 * n + 4 * fq;
                        f32x4 a = acc[ai][bj][m][n];
                        if (cscale) a = a * *(const f32x4*)(cscale + c);
                        const f32x4 o = *(const f32x4*)(xi + c) + *(const f32x4*)(gr + c) * a;
                        *(f32x4*)(X + (size_t)row * D + c) = o;
                    }
            }
    }
};

__device__ __forceinline__ float wave_sum(float v) {
#pragma unroll
    for (int o = 1; o < 64; o <<= 1) v += __shfl_xor(v, o);
    return v;
}
template <int CTRL> __device__ __forceinline__ unsigned dpp_u(unsigned v) { return (unsigned)__builtin_amdgcn_update_dpp(0, (int)v, CTRL, 0xf, 0xf, true); }
__device__ __forceinline__ unsigned wave_sum_u(unsigned v) {
    v += dpp_u<0xB1>(v); v += dpp_u<0x4E>(v); v += dpp_u<0x141>(v); v += dpp_u<0x140>(v);
    return (unsigned)__builtin_amdgcn_readlane((int)v, 0) + (unsigned)__builtin_amdgcn_readlane((int)v, 16) + (unsigned)__builtin_amdgcn_readlane((int)v, 32) + (unsigned)__builtin_amdgcn_readlane((int)v, 48);
}
__device__ __forceinline__ unsigned wave_max_u(unsigned v) {
    unsigned t;
    t = dpp_u<0xB1>(v); v = v > t ? v : t; t = dpp_u<0x4E>(v); v = v > t ? v : t; t = dpp_u<0x141>(v); v = v > t ? v : t; t = dpp_u<0x140>(v); v = v > t ? v : t;
    const unsigned a = (unsigned)__builtin_amdgcn_readlane((int)v, 0), b = (unsigned)__builtin_amdgcn_readlane((int)v, 16), c = (unsigned)__builtin_amdgcn_readlane((int)v, 32), d = (unsigned)__builtin_amdgcn_readlane((int)v, 48);
    const unsigned ab = a > b ? a : b, cd = c > d ? c : d; return ab > cd ? ab : cd;
}

__device__ __forceinline__ void transpose_item(const float* W, int N, bf16_t* WT, int ldo, int row_off, LAS float* scr, int kb, int nb, int lane) {
    const int k0 = 64 * kb, n0 = 32 * nb;
    const int n = n0 + (lane & 31);
#pragma unroll 8
    for (int i = 0; i < 32; ++i) { const int kk = 2 * i + (lane >> 5); scr[kk * 33 + (lane & 31)] = (n < N) ? W[(size_t)(k0 + kk) * N + n] : 0.f; }
    LDS_WAIT(); asm volatile("" ::: "memory");
    const int c = lane & 7;
#pragma unroll
    for (int j = 0; j < 4; ++j) { const int nn = (lane >> 3) + 8 * j; const LAS float* s = scr + (8 * c) * 33 + nn;
        u32x4 o; o.x = pk2(s[0 * 33], s[1 * 33]); o.y = pk2(s[2 * 33], s[3 * 33]); o.z = pk2(s[4 * 33], s[5 * 33]); o.w = pk2(s[6 * 33], s[7 * 33]);
        *(u32x4*)(WT + (size_t)(row_off + n0 + nn) * ldo + k0 + 8 * c) = o; }
    LDS_WAIT(); asm volatile("" ::: "memory");
}

__device__ __forceinline__ void p0a(Frame& F) {
    LAS float* scr = (LAS float*)(F.lds + F.wave * 16384);
    const int gw = F.bid * NWAVES + F.wave, NGW = F.G * NWAVES;
    constexpr int I_IN = (D / 64) * (NPROJ / 32), I_O = (D / 64) * (D / 32), I_P = 4 * (256 / 64) * (256 / 32), I_UP = (D / 64) * (DFF / 32), I_DN = (DFF / 64) * (D / 32);
    constexpr int NIT = I_IN + I_O + I_P + 2 * I_UP + 2 * I_DN + 144;
    for (int it = gw; it < NIT; it += NGW) {
        int r = it;
        if (r < I_IN) { transpose_item(F.w_in, DPROJ, F.WIN, D, 0, scr, r / (NPROJ / 32), r % (NPROJ / 32), F.lane); continue; } r -= I_IN;
        if (r < I_O) { transpose_item(F.w_o, D, F.WO, D, 0, scr, r / (D / 32), r % (D / 32), F.lane); continue; } r -= I_O;
        if (r < I_P) { const int g = r / 32, q = r % 32; transpose_item(F.pool_w + (size_t)g * 65536, 256, F.WPOOL, 256, g * 256, scr, q / 8, q % 8, F.lane); continue; } r -= I_P;
        if (r < 2 * I_UP) { const int l = r / I_UP, q = r % I_UP; transpose_item(F.w_up + (size_t)l * D * DFF, DFF, F.WUP + (size_t)l * D * DFF, D, 0, scr, q / (DFF / 32), q % (DFF / 32), F.lane); continue; } r -= 2 * I_UP;
        if (r < 2 * I_DN) { const int l = r / I_DN, q = r % I_DN; transpose_item(F.w_down + (size_t)l * D * DFF, D, F.WDN + (size_t)l * D * DFF, DFF, 0, scr, q / (D / 32), q % (D / 32), F.lane); continue; } r -= 2 * I_DN;
        {
            const float* c = r < NBATCH ? F.c_p + (size_t)r * D : F.c_s + (size_t)(r - NBATCH) * D;
#pragma unroll
            for (int j = 0; j < 4; ++j) {
                f32x4 v = {0.f, 0.f, 0.f, 0.f};
                if (r < NBROW) { v = *(const f32x4*)(c + 4 * F.lane + 256 * j);
#pragma unroll
                    for (int e = 0; e < 4; ++e) v[e] = v[e] * __builtin_amdgcn_rcpf(1.f + __expf(-v[e])); }
                u32x2 o; o.x = pk2(v[0], v[1]); o.y = pk2(v[2], v[3]);
                *(u32x2*)(F.SILU + (size_t)r * D + 4 * F.lane + 256 * j) = o;
            }
        }
    }
}
__device__ __forceinline__ void p0b(Frame& F) {
    const int gw = F.bid * NWAVES + F.wave, NGW = F.G * NWAVES;
    const int col = F.lane & 15, kq = F.lane >> 4;
    for (int task = gw; task < 2 * (NMOD / 16); task += NGW) {
        const int l = task / (NMOD / 16), n0 = (task % (NMOD / 16)) * 16;
        const float* W = F.w_mod + (size_t)l * D * NMOD + n0 + col;
        f32x4 acc[9];
#pragma unroll
        for (int i = 0; i < 9; ++i) acc[i] = (f32x4){0.f, 0.f, 0.f, 0.f};
#pragma unroll 2
        for (int ks = 0; ks < D / 32; ++ks) {
            const int k0 = 32 * ks + 8 * kq;
            float f[8];
#pragma unroll
            for (int j = 0; j < 8; ++j) f[j] = W[(size_t)(k0 + j) * NMOD];
            u32x4 bw; bw.x = pk2(f[0], f[1]); bw.y = pk2(f[2], f[3]); bw.z = pk2(f[4], f[5]); bw.w = pk2(f[6], f[7]);
            const bf16x8 bfr = __builtin_bit_cast(bf16x8, bw);
#pragma unroll
            for (int mt = 0; mt < 9; ++mt) {
                const bf16x8 a = *(const bf16x8*)(F.SILU + (size_t)(16 * mt + col) * D + k0);
                acc[mt] = __builtin_amdgcn_mfma_f32_16x16x32_bf16(a, bfr, acc[mt], 0, 0, 0);
            }
        }
        const float bias = F.b_mod[(size_t)l * NMOD + n0 + col];
#pragma unroll
        for (int mt = 0; mt < 9; ++mt)
#pragma unroll
            for (int r = 0; r < 4; ++r) { const int row = 16 * mt + 4 * kq + r; if (row < NBROW) F.MOD[((size_t)l * NBROW + row) * NMOD + n0 + col] = acc[mt][r] + bias; }
    }
}

template <int MODE>
__device__ __forceinline__ void rowpass(Frame& F, const float* src_p, const float* src_s, const float* gain, const float* mod_l, int sh_chunk, int sc_chunk, bf16_t* dst) {
    const int gw = F.bid * NWAVES + F.wave, NGW = F.G * NWAVES;
    for (int r = gw; r < MT; r += NGW) {
        const float* xr = r < MP ? src_p + (size_t)r * D : src_s + (size_t)(r - MP) * D;
        f32x4 v[4]; float s = 0.f;
#pragma unroll
        for (int j = 0; j < 4; ++j) { v[j] = *(const f32x4*)(xr + 4 * F.lane + 256 * j); s += (v[j].x * v[j].x + v[j].y * v[j].y) + (v[j].z * v[j].z + v[j].w * v[j].w); }
        const float rstd = __builtin_amdgcn_rsqf(wave_sum(s) * (1.f / D) + RMS_EPS);
        if (MODE == 2) {
            float* o = r < MP ? F.out + O_YP + (size_t)r * D : F.out + O_YS + (size_t)(r - MP) * D;
#pragma unroll
            for (int j = 0; j < 4; ++j) { const int c = 4 * F.lane + 256 * j; *(f32x4*)(o + c) = v[j] * rstd * *(const f32x4*)(gain + c); }
        } else {
            const float* mr = mod_l + (size_t)brow_of(r) * NMOD;
            float* po = nullptr;
            if (MODE == 1) {
                if (r < MP) { const int t = r & (SEQ - 1); if (t >= SEQ - POOLST) po = F.out + O_POOLP + ((size_t)(r >> 12) * POOLST + (t - (SEQ - POOLST))) * D; }
                else { const int q = r - MP; po = F.out + O_POOLS + ((size_t)(q >> 2) * POOLST + (POOLST - DECS) + (q & 3)) * D; }
            }
#pragma unroll
            for (int j = 0; j < 4; ++j) { const int c = 4 * F.lane + 256 * j;
                const f32x4 h = v[j] * rstd * *(const f32x4*)(gain + c) * (*(const f32x4*)(mr + sc_chunk * D + c) + 1.0f) + *(const f32x4*)(mr + sh_chunk * D + c);
                u32x2 o; o.x = pk2(h[0], h[1]); o.y = pk2(h[2], h[3]);
                *(u32x2*)(dst + (size_t)r * D + c) = o;
                if (MODE == 1 && po) *(f32x4*)(po + c) = h; }
        }
    }
    if (MODE == 1) {
        for (int it = gw; it < DECB * (POOLST - DECS); it += NGW) { const int seq = it / (POOLST - DECS), i = it % (POOLST - DECS);
            const float* s = F.state_pool + ((size_t)seq * POOLST + i + DECS) * D; float* o = F.out + O_POOLS + ((size_t)seq * POOLST + i) * D;
#pragma unroll
            for (int j = 0; j < 4; ++j) *(f32x4*)(o + 4 * F.lane + 256 * j) = *(const f32x4*)(s + 4 * F.lane + 256 * j); }
    }
}

__device__ __forceinline__ void poolpass(Frame& F, const bf16_t* H, bf16_t* PB) {
    const int gt = F.bid * NTHREADS + F.tid, NGT = F.G * NTHREADS;
    for (int it = gt; it < MT * 128; it += NGT) {
        const int r = it >> 7, c8 = it & 127, g = c8 >> 5, w = 2 << g;
        float s[8];
#pragma unroll
        for (int e = 0; e < 8; ++e) s[e] = 0.f;
        const u32x4 hv = *(const u32x4*)(H + (size_t)r * D + 8 * c8);
        float cnt;
        if (r < MP) {
            const int t = r & (SEQ - 1); const int n = (t + 1) < w ? (t + 1) : w; cnt = (float)n;
            for (int j = 0; j < n; ++j) { const u32x4 a = j == 0 ? hv : *(const u32x4*)(H + (size_t)(r - j) * D + 8 * c8);
                s[0] += bflo(a.x); s[1] += bfhi(a.x); s[2] += bflo(a.y); s[3] += bfhi(a.y); s[4] += bflo(a.z); s[5] += bfhi(a.z); s[6] += bflo(a.w); s[7] += bfhi(a.w); }
        } else {
            const int q = r - MP, seq = q >> 2, t = q & 3; cnt = (float)w;
            for (int j = 0; j < w; ++j) { const int e = t - j;
                if (e >= 0) { const u32x4 a = j == 0 ? hv : *(const u32x4*)(H + (size_t)(r - j) * D + 8 * c8);
                    s[0] += bflo(a.x); s[1] += bfhi(a.x); s[2] += bflo(a.y); s[3] += bfhi(a.y); s[4] += bflo(a.z); s[5] += bfhi(a.z); s[6] += bflo(a.w); s[7] += bfhi(a.w); }
                else { const float* p = F.state_pool + ((size_t)seq * POOLST + POOLST + e) * D + 8 * c8; const f32x4 a = *(const f32x4*)p, b = *(const f32x4*)(p + 4);
                    s[0] += a[0]; s[1] += a[1]; s[2] += a[2]; s[3] += a[3]; s[4] += b[0]; s[5] += b[1]; s[6] += b[2]; s[7] += b[3]; } }
        }
        const float ic = __builtin_amdgcn_rcpf(cnt);
        u32x4 o; o.x = pk2(s[0] * ic - bflo(hv.x), s[1] * ic - bfhi(hv.x)); o.y = pk2(s[2] * ic - bflo(hv.y), s[3] * ic - bfhi(hv.y));
        o.z = pk2(s[4] * ic - bflo(hv.z), s[5] * ic - bfhi(hv.z)); o.w = pk2(s[6] * ic - bflo(hv.w), s[7] * ic - bfhi(hv.w));
        *(u32x4*)(PB + (size_t)r * D + 8 * c8) = o;
    }
}

__device__ __forceinline__ unsigned okey(float f) { const unsigned u = __float_as_uint(f); return (u & 0x80000000u) ? ~u : (u | 0x80000000u); }
__device__ __forceinline__ bf16x8 ld8_bf(const bf16_t* p) { return *(const bf16x8*)p; }
__device__ __forceinline__ bf16x8 ld8_f32(const float* p) { const f32x4 a = *(const f32x4*)p, b = *(const f32x4*)(p + 4); return pack8(a, b); }
__device__ __forceinline__ s16x4 vtr(const LAS unsigned char* p) { typedef short v4i16_t __attribute__((ext_vector_type(4))); return __builtin_bit_cast(s16x4, __builtin_amdgcn_ds_read_tr16_b64_v4i16((LAS v4i16_t*)p)); }

template <bool SAMPLE>
__device__ __forceinline__ void dsa_item(Frame& F, int item) {
    constexpr int NQ = SAMPLE ? 4 : 8, NG = SAMPLE ? 1 : 2, NREG = SAMPLE ? 33 : 64;
    int lane = F.lane; asm volatile("" : "+v"(lane));
    const int w = F.wave;
    LAS float* SC = (LAS float*)F.lds;
    LAS unsigned short* IDXL = (LAS unsigned short*)(F.lds + IDXL_OFF);
    const int b = SAMPLE ? item : (item & 3), t0 = SAMPLE ? PAST : (item >> 2) * 8;
    const int row0 = SAMPLE ? MP + item * DECS : b * SEQ + t0;
    const int* pt = F.page_table + (SAMPLE ? item * PAGES_PER_SEQ : 0);
    {
        const int r = lane & 31, hk = lane >> 5, hi = hk;
        const int q4 = (r >> 4) + 2 * ((r >> 2) & 1), head = (r & 3) + 4 * ((r >> 3) & 1);
        bf16x8 afr[NG][4]; float wiA[NG][8], wiB[NG][8];
        const float cs = 0.125f * 0.35355339059327373f;
#pragma unroll
        for (int G = 0; G < NG; ++G) {
#pragma unroll
            for (int c = 0; c < 4; ++c) afr[G][c] = ld8_bf(F.QIB + (size_t)(row0 + 4 * G + q4) * QIW + head * IDD + 16 * c + 8 * hk);
            const float* wa = F.WIF + (size_t)(row0 + 4 * G + 2 * hi) * 8;
#pragma unroll
            for (int h = 0; h < 8; ++h) { wiA[G][h] = wa[h] * cs; wiB[G][h] = wa[8 + h] * cs; }
        }
        const int nkt = SAMPLE ? 65 : (t0 + 8 + 31) / 32;
        for (int kt = w; kt < nkt; kt += NWAVES) {
            const int s = 32 * kt + r;
            bf16x8 bfr[4];
            if (SAMPLE) {
                const int sc = s < PAST + DECS - 1 ? s : PAST + DECS - 1;
                const float* kp = sc < PAST ? F.cache_ki + ((size_t)pt[sc >> 7] * PAGE + (sc & (PAGE - 1))) * IDD : F.out + O_KIS + (size_t)(item * DECS + sc - PAST) * IDD;
#pragma unroll
                for (int c = 0; c < 4; ++c) bfr[c] = ld8_f32(kp + 16 * c + 8 * hk);
            } else {
                const bf16_t* kp = F.KIB + (size_t)(b * SEQ + s) * IDD;
#pragma unroll
                for (int c = 0; c < 4; ++c) bfr[c] = ld8_bf(kp + 16 * c + 8 * hk);
            }
#pragma unroll
            for (int G = 0; G < NG; ++G) {
                f32x16 acc;
#pragma unroll
                for (int i = 0; i < 16; ++i) acc[i] = 0.f;
#pragma unroll
                for (int c = 0; c < 4; ++c) acc = __builtin_amdgcn_mfma_f32_32x32x16_bf16(afr[G][c], bfr[c], acc, 0, 0, 0);
                float sA = 0.f, sB = 0.f;
#pragma unroll
                for (int h = 0; h < 8; ++h) { sA += fmaxf(acc[h], 0.f) * wiA[G][h]; sB += fmaxf(acc[8 + h], 0.f) * wiB[G][h]; }
                SC[(4 * G + 2 * hi) * 4096 + s] = sA + 0.0f; SC[(4 * G + 2 * hi + 1) * 4096 + s] = sB + 0.0f;
            }
        }
    }
    __syncthreads();
    if (w < NQ) {
        asm volatile("" : "+v"(lane));
        const int pos = t0 + w, nvalid = pos + 1;
        const int nsel = nvalid < TOPK ? nvalid : TOPK;
        LAS unsigned short* IL = IDXL + w * 256;
        if (nvalid <= TOPK) {
#pragma unroll
            for (int i = 0; i < 4; ++i) { const int p = lane + 64 * i; IL[p] = (unsigned short)(p < nvalid ? p : 0); }
        } else {
            const LAS float* scl = SC + w * 4096 + lane; asm volatile("" : "+v"(scl));
            constexpr int NCH = (NREG + 7) / 8;
            const int nch = (nvalid + 511) >> 9;
            unsigned u[NCH * 8]; unsigned mx = 0u;
#pragma unroll
            for (int c = 0; c < NCH; ++c) {
#pragma unroll
                for (int j = 0; j < 8; ++j) u[8 * c + j] = 0u;
                if (c < nch) {
#pragma unroll
                    for (int j = 0; j < 8; ++j) { const int s = 64 * (8 * c + j) + lane; const unsigned k = okey(scl[64 * (8 * c + j)]); u[8 * c + j] = s < nvalid ? k : 0u; mx = mx > u[8 * c + j] ? mx : u[8 * c + j]; }
                }
            }
            mx = wave_max_u(mx);
#define DSA_COUNT(res, thr) do { unsigned c_ = 0u; _Pragma("unroll") for (int cc_ = 0; cc_ < NCH; ++cc_) { if (cc_ < nch) { _Pragma("unroll") for (int j_ = 0; j_ < 8; ++j_) c_ += (u[8 * cc_ + j_] >= (thr)) ? 1u : 0u; } } res = wave_sum_u(c_); } while (0)
            unsigned lo = 0u, hi = mx + 1u; bool done = false;
            if (mx > 0x80000000u + (3u << 23)) { const unsigned tr = mx - (3u << 23); unsigned c; DSA_COUNT(c, tr); if (c >= (unsigned)TOPK) lo = tr; else hi = tr; done = (c == (unsigned)TOPK); }
            while (!done && hi - lo > 1u) { const unsigned mid = lo + ((hi - lo) >> 1); unsigned c; DSA_COUNT(c, mid); if (c >= (unsigned)TOPK) lo = mid; else hi = mid; done = (c == (unsigned)TOPK); }
            const unsigned T = lo; unsigned ngt; DSA_COUNT(ngt, T + 1u);
#undef DSA_COUNT
            const unsigned need_eq = (unsigned)TOPK - ngt;
            unsigned base = 0u, eqb = 0u;
#pragma unroll
            for (int c = 0; c < NCH; ++c) {
                if (c < nch) {
#pragma unroll
                    for (int j = 0; j < 8; ++j) {
                        const int i = 8 * c + j;
                        const bool gt = u[i] > T, eq = u[i] == T;
                        const unsigned long long be = __ballot(eq);
                        const unsigned er = eqb + __builtin_amdgcn_mbcnt_hi((unsigned)(be >> 32), __builtin_amdgcn_mbcnt_lo((unsigned)be, 0u));
                        const bool sel = gt || (eq && er < need_eq);
                        const unsigned long long bs = __ballot(sel);
                        const unsigned p = base + __builtin_amdgcn_mbcnt_hi((unsigned)(bs >> 32), __builtin_amdgcn_mbcnt_lo((unsigned)bs, 0u));
                        if (sel && p < (unsigned)TOPK) IL[p] = (unsigned short)(64 * i + lane);
                        base += (unsigned)__popcll(bs); eqb += (unsigned)__popcll(be);
                    }
                }
            }
        }
        LDS_WAIT(); asm volatile("" ::: "memory");
        asm volatile("" : "+v"(lane));
        const int col = lane & 15, kq = lane >> 4;
        const int nblk = (nsel + 31) >> 5;
        const int qrow = row0 + w;
        bf16x8 Bq0[4], Bq1[4];
#pragma unroll
        for (int c = 0; c < 4; ++c) {
            bf16x8 qv = (bf16x8){0, 0, 0, 0, 0, 0, 0, 0};
            if (col < 8) qv = ld8_bf(F.QB + (size_t)qrow * D + col * HD + 32 * c + 8 * kq);
            Bq0[c] = col < 4 ? qv : (bf16x8){0, 0, 0, 0, 0, 0, 0, 0}; Bq1[c] = col >= 4 ? qv : (bf16x8){0, 0, 0, 0, 0, 0, 0, 0};
        }
        auto krow_f = [&](int key) -> const float* { return key < PAST ? F.cache_k + ((size_t)pt[key >> 7] * PAGE + (key & (PAGE - 1))) * KVW : F.out + O_KS + (size_t)(item * DECS + key - PAST) * KVW; };
        auto vrow_f = [&](int key) -> const float* { return key < PAST ? F.cache_v + ((size_t)pt[key >> 7] * PAGE + (key & (PAGE - 1))) * KVW : F.out + O_VS + (size_t)(item * DECS + key - PAST) * KVW; };
        f32x4 S[16];
#pragma unroll
        for (int t = 0; t < 16; ++t) {
            S[t] = (f32x4){0.f, 0.f, 0.f, 0.f};
            if (16 * t < 32 * nblk) {
                const int key = IL[16 * t + col];
                bf16x8 kf[2][4];
                if (SAMPLE) { const float* kp = krow_f(key);
#pragma unroll
                    for (int g = 0; g < 2; ++g)
#pragma unroll
                        for (int c = 0; c < 4; ++c) kf[g][c] = ld8_f32(kp + g * HD + 32 * c + 8 * kq);
                } else { const bf16_t* kp = F.KB + (size_t)(b * SEQ + key) * KVW;
#pragma unroll
                    for (int g = 0; g < 2; ++g)
#pragma unroll
                        for (int c = 0; c < 4; ++c) kf[g][c] = ld8_bf(kp + g * HD + 32 * c + 8 * kq);
                }
#pragma unroll
                for (int c = 0; c < 4; ++c) S[t] = __builtin_amdgcn_mfma_f32_16x16x32_bf16(kf[0][c], Bq0[c], S[t], 0, 0, 0);
#pragma unroll
                for (int c = 0; c < 4; ++c) S[t] = __builtin_amdgcn_mfma_f32_16x16x32_bf16(kf[1][c], Bq1[c], S[t], 0, 0, 0);
            }
        }
        float mxs = -INFINITY;
#pragma unroll
        for (int t = 0; t < 16; ++t)
#pragma unroll
            for (int r = 0; r < 4; ++r) { const int p = 16 * t + 4 * kq + r; if (p >= nsel) S[t][r] = -INFINITY; mxs = fmaxf(mxs, S[t][r]); }
        mxs = fmaxf(mxs, __shfl_xor(mxs, 16)); mxs = fmaxf(mxs, __shfl_xor(mxs, 32));
        const float c2 = 0.08838834764831845f * 1.4426950408889634f;
        float lsum = 0.f;
#pragma unroll
        for (int t = 0; t < 16; ++t)
#pragma unroll
            for (int r = 0; r < 4; ++r) { const float p = __builtin_amdgcn_exp2f((S[t][r] - mxs) * c2); S[t][r] = p; lsum += p; }
        lsum += __shfl_xor(lsum, 16); lsum += __shfl_xor(lsum, 32);
        bf16x8 PA[8];
#pragma unroll
        for (int i = 0; i < 8; ++i) PA[i] = pack8(S[2 * i], S[2 * i + 1]);
        f32x4 O[2][8];
#pragma unroll
        for (int g = 0; g < 2; ++g)
#pragma unroll
            for (int dt = 0; dt < 8; ++dt) O[g][dt] = (f32x4){0.f, 0.f, 0.f, 0.f};
        LAS unsigned char* vst = F.lds + w * 16384;
        const int q_ = (lane & 15) >> 2, p_ = lane & 3;
#pragma unroll
        for (int i = 0; i < 8; ++i) {
            if (i < nblk) {
#pragma unroll
                for (int hb = 0; hb < 2; ++hb) {
                    u32x4 vv[8];
#pragma unroll
                    for (int ld = 0; ld < 8; ++ld) { const int slot = 16 * hb + 2 * ld + (lane >> 5), ch = lane & 31; const int key = IL[32 * i + slot];
                        if (SAMPLE) vv[ld] = __builtin_bit_cast(u32x4, ld8_f32(vrow_f(key) + 8 * ch));
                        else vv[ld] = *(const u32x4*)(F.VB + (size_t)(b * SEQ + key) * KVW + 8 * ch); }
#pragma unroll
                    for (int ld = 0; ld < 8; ++ld) { const int slot = 16 * hb + 2 * ld + (lane >> 5), ch = lane & 31;
                        *(LAS u32x4*)(vst + slot * 512 + ((ch ^ ((slot & 7) << 1)) << 4)) = vv[ld]; }
                }
                LDS_WAIT(); asm volatile("" ::: "memory");
#pragma unroll
                for (int g = 0; g < 2; ++g)
#pragma unroll
                    for (int dt = 0; dt < 8; ++dt) {
                        const int ch = g * 16 + dt * 2 + (p_ >> 1);
                        const int s0 = 4 * kq + q_, s1 = 16 + 4 * kq + q_;
                        const s16x4 lo = vtr(vst + s0 * 512 + ((ch ^ ((s0 & 7) << 1)) << 4) + (p_ & 1) * 8);
                        const s16x4 hi = vtr(vst + s1 * 512 + ((ch ^ ((s1 & 7) << 1)) << 4) + (p_ & 1) * 8);
                        const bf16x8 bv = (bf16x8){lo[0], lo[1], lo[2], lo[3], hi[0], hi[1], hi[2], hi[3]};
                        O[g][dt] = __builtin_amdgcn_mfma_f32_16x16x32_bf16(PA[i], bv, O[g][dt], 0, 0, 0);
                    }
                LDS_WAIT(); asm volatile("" ::: "memory");
            }
        }
        float inv[8];
#pragma unroll
        for (int h = 0; h < 8; ++h) inv[h] = __builtin_amdgcn_rcpf(__shfl(lsum, h));
        if (kq < 2) {
            bf16_t* ob = F.OB + (size_t)qrow * D;
#pragma unroll
            for (int dt = 0; dt < 8; ++dt)
#pragma unroll
                for (int r = 0; r < 4; ++r) {
                    const float v = kq == 0 ? O[0][dt][r] * inv[r] : O[1][dt][r] * inv[4 + r];
                    ob[(4 * kq + r) * HD + 16 * dt + col] = (bf16_t)(pk2(v, 0.f) & 0xffffu);
                }
        }
    }
    __syncthreads();
}
__device__ __forceinline__ void dsa_phase(Frame& F) {
    for (int k = F.bid; k < MP / 8; k += F.G) { const int kk = ((k >> 8) & 1) ? (k ^ 255) : k; dsa_item<false>(F, kk); }
    for (int s = F.bid; s < DECB; s += F.G) dsa_item<true>(F, s);
}

__global__ void __launch_bounds__(NTHREADS, 2) fwd_megakernel(Params P) {
    extern __shared__ __attribute__((aligned(16))) unsigned char lds_raw[];
    Frame F;
#define BUILD_FRAME() do { \
    int tid_ = threadIdx.x; asm volatile("" : "+v"(tid_)); \
    unsigned char* ws_ = P.ws; asm volatile("" : "+s"(ws_)); float* out_ = P.out; asm volatile("" : "+s"(out_)); \
    F.lds = (LAS unsigned char*)lds_raw; \
    F.tid = tid_; F.lane = F.tid & 63; F.wave = __builtin_amdgcn_readfirstlane(F.tid >> 6); F.G = gridDim.x; F.bid = blockIdx.x; \
    F.x_p = P.in[0]; F.x_s = P.in[1]; F.cache_k = P.in[2]; F.cache_v = P.in[3]; F.cache_ki = P.in[4]; F.state_pool = P.in[5]; F.page_table = (const int*)P.in[6]; \
    F.c_p = P.in[7]; F.c_s = P.in[8]; F.g_mix = P.in[9]; F.g_ffn = P.in[10]; F.w_mod = P.in[11]; F.b_mod = P.in[12]; F.w_in = P.in[13]; F.w_o = P.in[14]; \
    F.pool_w = P.in[15]; F.pool_scale = P.in[16]; F.w_up = P.in[17]; F.w_down = P.in[18]; F.g_final = P.in[19]; \
    F.out = out_; F.ws = ws_; \
    F.MOD = (float*)(ws_ + WS_MOD); F.SILU = (bf16_t*)(ws_ + WS_SILU); F.WIN = (bf16_t*)(ws_ + WS_WIN); F.WO = (bf16_t*)(ws_ + WS_WO); F.WPOOL = (bf16_t*)(ws_ + WS_WPOOL); \
    F.WUP = (bf16_t*)(ws_ + WS_WUP); F.WDN = (bf16_t*)(ws_ + WS_WDN); F.HB = (bf16_t*)(ws_ + WS_HB); F.QB = (bf16_t*)(ws_ + WS_QB); F.KB = (bf16_t*)(ws_ + WS_KB); F.VB = (bf16_t*)(ws_ + WS_VB); \
    F.QIB = (bf16_t*)(ws_ + WS_QIB); F.KIB = (bf16_t*)(ws_ + WS_KIB); F.WIF = (float*)(ws_ + WS_WIF); F.OB = (bf16_t*)(ws_ + WS_OB); F.X = (float*)(ws_ + WS_X); F.UB = (bf16_t*)(ws_ + WS_UB); \
    mod0 = F.MOD; mod1 = F.MOD + (size_t)NBROW * NMOD; } while (0)
    const float* mod0; const float* mod1;
    unsigned char* ws = P.ws;
    volatile LAS unsigned* MISC = (volatile LAS unsigned*)((LAS unsigned char*)lds_raw + MISC_OFF);
    for (int u = threadIdx.x; u < 64; u += NTHREADS) MISC[u] = 0u;
    __syncthreads();
    XcdBarrier bar = xcd_barrier_post((unsigned*)(ws + WS_CTL) + CW_BAR, MISC + 8);
#define GRID_BAR() do { xcd_barrier(bar); BUILD_FRAME(); } while (0)

    BUILD_FRAME();
    p0a(F);
    cg::this_grid().sync();
    BUILD_FRAME();
    p0b(F);
    GRID_BAR();
    rowpass<0>(F, F.x_p, F.x_s, F.g_mix, mod0, 0, 1, F.HB);
    GRID_BAR();
    {   pg8::Gemm g{F.HB, F.WIN, MT, NPROJ, D, D, D, 0}; pg8::StaticOrder S; S.init(MT, NPROJ, F.G, F.bid);
        EpiProj E{F.QB, F.KB, F.VB, F.QIB, F.KIB, F.WIF, F.out};
        pg8::gemm_phase<EpiProj, pg8::StaticOrder, true>(F.lds, g, S, E); }
    GRID_BAR();
    dsa_phase(F);
    GRID_BAR();
    {   pg8::Gemm g{F.OB, F.WO, MT, D, D, D, D, 0}; pg8::StaticOrder S; S.init(MT, D, F.G, F.bid);
        EpiRes E{F.x_p, F.x_s, F.X, mod0 + 2 * D, nullptr};
        pg8::gemm_phase<EpiRes, pg8::StaticOrder, true>(F.lds, g, S, E); }
    GRID_BAR();
    rowpass<0>(F, F.X, F.X + (size_t)MP * D, F.g_ffn, mod0, 3, 4, F.HB);
    GRID_BAR();
    {   pg8::Gemm g{F.HB, F.WUP, MT, DFF, D, D, D, 0}; pg8::StaticOrder S; S.init(MT, DFF, F.G, F.bid);
        EpiUp E{F.UB};
        pg8::gemm_phase<EpiUp, pg8::StaticOrder, true>(F.lds, g, S, E); }
    GRID_BAR();
    {   pg8::Gemm g{F.UB, F.WDN, MT, D, DFF, DFF, DFF, 0}; pg8::StaticOrder S; S.init(MT, D, F.G, F.bid);
        EpiRes E{F.X, F.X + (size_t)MP * D, F.X, mod0 + 5 * D, nullptr};
        pg8::gemm_phase<EpiRes, pg8::StaticOrder, true>(F.lds, g, S, E); }
    GRID_BAR();
    rowpass<1>(F, F.X, F.X + (size_t)MP * D, F.g_mix + D, mod1, 0, 1, F.HB);
    GRID_BAR();
    poolpass(F, F.HB, F.OB);
    GRID_BAR();
    {   pg8::Gemm g{F.OB, F.WPOOL, MT, D, 256, D, 256, 256}; pg8::StaticOrder S; S.init(MT, D, F.G, F.bid);
        EpiRes E{F.X, F.X + (size_t)MP * D, F.X, mod1 + 2 * D, F.pool_scale};
        pg8::gemm_phase<EpiRes, pg8::StaticOrder, true>(F.lds, g, S, E); }
    GRID_BAR();
    rowpass<0>(F, F.X, F.X + (size_t)MP * D, F.g_ffn + D, mod1, 3, 4, F.HB);
    GRID_BAR();
    {   pg8::Gemm g{F.HB, F.WUP + (size_t)D * DFF, MT, DFF, D, D, D, 0}; pg8::StaticOrder S; S.init(MT, DFF, F.G, F.bid);
        EpiUp E{F.UB};
        pg8::gemm_phase<EpiUp, pg8::StaticOrder, true>(F.lds, g, S, E); }
    GRID_BAR();
    {   pg8::Gemm g{F.UB, F.WDN + (size_t)D * DFF, MT, D, DFF, DFF, DFF, 0}; pg8::StaticOrder S; S.init(MT, D, F.G, F.bid);
        EpiRes E{F.X, F.X + (size_t)MP * D, F.X, mod1 + 5 * D, nullptr};
        pg8::gemm_phase<EpiRes, pg8::StaticOrder, true>(F.lds, g, S, E); }
    GRID_BAR();
    rowpass<2>(F, F.X, F.X + (size_t)MP * D, F.g_final, nullptr, 0, 0, nullptr);
}

extern "C" void kernel_launch(void* const* d_in, const int* in_sizes, int n_in, void* d_out, int out_size, void* d_ws, size_t ws_size, hipStream_t stream) {
    static int grid = 0;
    if (grid == 0) {
        if (n_in != 20 || (size_t)out_size != O_END || ws_size < WS_END) { fprintf(stderr, "kernel_launch: unexpected shapes (n_in %d out %d ws %zu)\n", n_in, out_size, ws_size); grid = -1; return; }
        int dev = 0, cus = 0, per_cu = 0;
        if (hipGetDevice(&dev) != hipSuccess || hipDeviceGetAttribute(&cus, hipDeviceAttributeMultiprocessorCount, dev) != hipSuccess) { grid = -1; return; }
        if (hipFuncSetAttribute((const void*)fwd_megakernel, hipFuncAttributeMaxDynamicSharedMemorySize, LDS_BYTES) != hipSuccess) { fprintf(stderr, "kernel_launch: hipFuncSetAttribute failed\n"); grid = -1; return; }
        if (hipOccupancyMaxActiveBlocksPerMultiprocessor(&per_cu, (const void*)fwd_megakernel, NTHREADS, LDS_BYTES) != hipSuccess || per_cu < 1) { fprintf(stderr, "kernel_launch: occupancy query failed (%d)\n", per_cu); (void)hipGetLastError(); grid = -1; return; }
        grid = cus;
    }
    if (grid < 0) return;
    (void)hipMemsetAsync((char*)d_ws + WS_CTL, 0, CTL_ZERO_BYTES, stream);
    Params p{};
    for (int i = 0; i < 20; ++i) p.in[i] = (const float*)d_in[i];
    p.out = (float*)d_out; p.ws = (unsigned char*)d_ws;
    void* args[] = {&p};
    hipError_t e = hipLaunchCooperativeKernel((const void*)fwd_megakernel, dim3(grid), dim3(NTHREADS), args, LDS_BYTES, stream);
    if (e != hipSuccess) fprintf(stderr, "cooperative launch failed: %s (grid %d)\n", hipGetErrorString(e), grid);
}
```

```cpp
#include <hip/hip_runtime.h>
#include <hip/hip_cooperative_groups.h>
#include <cstdio>
#include <cstdint>
namespace cg = cooperative_groups;

#define LAS __attribute__((address_space(3)))
typedef unsigned short bf16_t;
typedef short bf16x8 __attribute__((ext_vector_type(8)));
typedef short s16x4 __attribute__((ext_vector_type(4)));
typedef float f32x2 __attribute__((ext_vector_type(2)));
typedef float f32x4 __attribute__((ext_vector_type(4)));
typedef float f32x16 __attribute__((ext_vector_type(16)));
typedef unsigned u32x2 __attribute__((ext_vector_type(2)));
typedef unsigned u32x4 __attribute__((ext_vector_type(4)));
typedef __bf16 bf16x2_t __attribute__((ext_vector_type(2)));

constexpr int D = 1024, NBATCH = 4, SEQ = 4096, MP = NBATCH * SEQ, DECB = 128, DECS = 4, MS = DECB * DECS, MT = MP + MS;
constexpr int PAST = 2048, PAGE = 128, PAGES_PER_SEQ = 16;
constexpr int NH = 8, HD = 128, NKV = 2, KVW = NKV * HD, IH = 8, IDD = 64, QIW = IH * IDD, TOPK = 256;
constexpr int DFF = 4096, DPROJ = 2120, NPROJ = 2304, NMOD = 6 * D, NBROW = NBATCH + DECB;
constexpr int POOLST = 15;
constexpr float RMS_EPS = 1e-6f;
constexpr size_t O_YP = 0, O_YS = O_YP + (size_t)MP * D, O_KP = O_YS + (size_t)MS * D, O_VP = O_KP + (size_t)MP * KVW, O_KIP = O_VP + (size_t)MP * KVW,
                 O_POOLP = O_KIP + (size_t)MP * IDD, O_KS = O_POOLP + (size_t)NBATCH * POOLST * D, O_VS = O_KS + (size_t)MS * KVW, O_KIS = O_VS + (size_t)MS * KVW,
                 O_POOLS = O_KIS + (size_t)MS * IDD, O_END = O_POOLS + (size_t)DECB * POOLST * D;
constexpr size_t MiB = 1u << 20;
constexpr size_t WS_CTL = 0, CTL_ZERO_BYTES = 1 * MiB, WS_MOD = 1 * MiB, WS_SILU = 8 * MiB, WS_WIN = 9 * MiB, WS_WO = 14 * MiB, WS_WPOOL = 16 * MiB, WS_WUP = 17 * MiB,
                 WS_WDN = 33 * MiB, WS_HB = 49 * MiB, WS_QB = 82 * MiB, WS_KB = 115 * MiB, WS_VB = 124 * MiB, WS_QIB = 133 * MiB, WS_KIB = 150 * MiB, WS_WIF = 153 * MiB,
                 WS_OB = 154 * MiB, WS_X = 187 * MiB, WS_UB = 253 * MiB, WS_IL = 385 * MiB, WS_END = 394 * MiB;
constexpr int CW_BAR = 4096;
constexpr int RING_BYTES = 131072, IDXL_OFF = RING_BYTES, MISC_OFF = IDXL_OFF + 4096, HIST_OFF = MISC_OFF + 256, LDS_BYTES = 147456;
static_assert(HIST_OFF + 8 * 1024 <= LDS_BYTES, "LDS map");
constexpr int NWAVES = 8, NTHREADS = 512;

#define GAS __attribute__((address_space(1)))
template <class T> __device__ __forceinline__ T* as_global(T* p) { GAS T* g = (GAS T*)p; asm volatile("" : "+s"(g)); return (T*)g; }
__device__ __forceinline__ unsigned pk2(float lo, float hi) { f32x2 v = {lo, hi}; bf16x2_t b = __builtin_convertvector(v, bf16x2_t); return __builtin_bit_cast(unsigned, b); }
__device__ __forceinline__ float bflo(unsigned u) { return __uint_as_float(u << 16); }
__device__ __forceinline__ float bfhi(unsigned u) { return __uint_as_float(u & 0xffff0000u); }
__device__ __forceinline__ bf16x8 pack8(f32x4 a, f32x4 b) { u32x4 w; w.x = pk2(a[0], a[1]); w.y = pk2(a[2], a[3]); w.z = pk2(b[0], b[1]); w.w = pk2(b[2], b[3]); return __builtin_bit_cast(bf16x8, w); }
#define LDS_WAIT() asm volatile("s_waitcnt lgkmcnt(0)" ::: "memory")
#define VM_WAIT() asm volatile("s_waitcnt vmcnt(0)" ::: "memory")

namespace pg8 {
constexpr int BM = 256, BK = 64, HALF = 128, HTB = HALF * BK * 2, STAGE_BYTES = 8 * HTB, NXCD = 8, WGM = 8;
__host__ __device__ __forceinline__ int lds_byte(int r, int c) { const int st = (r >> 4) * 2 + (c >> 5), rr = r & 15, cc = c & 31, ob = rr * 64 + cc * 2; return st * 1024 + (ob ^ (((ob >> 9) & 1) << 5)); }
__host__ __device__ __forceinline__ void stage_rc(int b, int& R, int& C) { const int st = b / 1024, sb = b % 1024, swz = sb ^ (((sb >> 9) & 1) << 5); R = (st >> 1) * 16 + swz / 64; C = (st & 1) * 32 + (swz % 64) / 2; }
__host__ __device__ __forceinline__ int perm32(int rho) { const int n = rho >> 4, i = rho & 15; return 8 * (i >> 2) + 4 * n + (i & 3); }
struct Unit { int pm, pn, k0, nt; bool atomic; };
struct Gemm { const bf16_t* A; const bf16_t* Bt; int M, N, K, lda, ldb, acol; };
struct MixOrder {
    int nMp, nMs, nN, nP, nS, S, ntFull, G, c;
    __device__ void init(int Mp, int Ms, int N, int K, int S_, int G_, int c_) { nMp = Mp / BM; nMs = Ms / BM; nN = N / BM; nP = nMp * nN; S = S_; nS = nMs * nN * S; ntFull = K / BK; G = G_; c = c_; }
    __device__ bool next(int i, Unit& u) const {
        const long L = (long)i * G + c; if (L >= nP + nS) return false;
        if (L < nP) {
            int wgid = (int)L; { const int q = nP / NXCD, r = nP % NXCD, xcd = wgid % NXCD, off = wgid / NXCD; wgid = (xcd < r ? xcd * (q + 1) : r * (q + 1) + (xcd - r) * q) + off; }
            const int nig = WGM * nN, gid = wgid / nig, fm = gid * WGM, gsz = (nMp - fm) < WGM ? (nMp - fm) : WGM;
            u.pm = fm + ((wgid % nig) % gsz); u.pn = (wgid % nig) / gsz; u.k0 = 0; u.nt = ntFull; u.atomic = false;
        } else {
            const int s_ = (int)L - nP, ks = s_ % S, q = s_ / S;
            u.pn = q % nN; u.pm = nMp + q / nN; u.nt = ntFull / S; u.k0 = ks * u.nt; u.atomic = S > 1;
        }
        return true;
    }
    __device__ __forceinline__ void a_ready(const Unit&) const {}
    __device__ __forceinline__ void done(const Unit&) const {}
};

template <class Epi, class Sched, bool ALIGN_EPI>
__device__ __forceinline__ void gemm_phase(LAS unsigned char* lds, const Gemm g, const Sched& S, const Epi& E) {
    int tid_ = threadIdx.x; asm volatile("" : "+v"(tid_));
    const int tid = tid_, wid = __builtin_amdgcn_readfirstlane(tid >> 6), lane = tid & 63, wr = wid >> 2, wc = wid & 3, fr = lane & 15, fq = lane >> 4;
    unsigned voffA[2], voffB[2];
#pragma unroll
    for (int i = 0; i < 2; ++i) { int R, C; stage_rc(tid * 16 + i * 8192, R, C); const int Rb = Epi::PERM ? ((R & ~31) + perm32(R & 31)) : R;
        voffA[i] = (unsigned)(R * g.lda + C) * 2u; voffB[i] = (unsigned)(Rb * g.ldb + C) * 2u; }
    const size_t kstep = (size_t)(BK * 2);
    const size_t hstepA = (size_t)HALF * g.lda * 2, hstepB = (size_t)HALF * g.ldb * 2;
    const size_t tstepA = 2 * hstepA, tstepB = 2 * hstepB;
    const unsigned ldsw = (unsigned)wid * 1024u;
    const int aoff = lds_byte(wr * 64 + fr, fq * 8), boff = lds_byte(wc * 32 + fr, fq * 8);
#define PG8_SA(b, h) (((b) * 2 + (h)) * HTB)
#define PG8_SB(b, h) ((4 + (b) * 2 + (h)) * HTB)
#define PG8_STAGE(bufoff, gbase, voff) do { _Pragma("unroll") for (int _i = 0; _i < 2; ++_i) \
        __builtin_amdgcn_global_load_lds((const unsigned*)((const char*)(gbase) + (voff)[_i]), (LAS unsigned*)(lds + (bufoff) + ldsw + _i * 8192), 16, 0, 0); } while (0)
#define PG8_LDA(dst, b, h) do { _Pragma("unroll") for (int m = 0; m < 4; ++m) _Pragma("unroll") for (int k = 0; k < 2; ++k) dst[m][k] = *(const LAS bf16x8*)(lds + PG8_SA(b, h) + aoff + m * 2048 + k * 1024); } while (0)
#define PG8_LDB(dst, b, h) do { _Pragma("unroll") for (int n = 0; n < 2; ++n) _Pragma("unroll") for (int k = 0; k < 2; ++k) dst[n][k] = *(const LAS bf16x8*)(lds + PG8_SB(b, h) + boff + n * 2048 + k * 1024); } while (0)
#define PG8_MMA(ai, bj, At, Bt) do { __builtin_amdgcn_s_setprio(1); _Pragma("unroll") for (int m = 0; m < 4; ++m) _Pragma("unroll") for (int n = 0; n < 2; ++n) _Pragma("unroll") for (int k = 0; k < 2; ++k) \
        acc[ai][bj][m][n] = __builtin_amdgcn_mfma_f32_16x16x32_bf16(Bt[n][k], At[m][k], acc[ai][bj][m][n], 0, 0, 0); __builtin_amdgcn_s_setprio(0); } while (0)
#define PG8_WAIT_V(n) asm volatile("s_waitcnt vmcnt(" #n ")" ::: "memory")
#define PG8_WAIT_L(n) asm volatile("s_waitcnt lgkmcnt(" #n ")" ::: "memory")
#define PG8_BAR __builtin_amdgcn_s_barrier()
#define PG8_SCHED __builtin_amdgcn_sched_barrier(0)
#define PG8_UA(u) ((const char*)g.A + (size_t)(u).pm * tstepA + (size_t)(u).pn * (size_t)g.acol * 2 + (size_t)(u).k0 * kstep)
#define PG8_UB(u) ((const char*)g.Bt + (size_t)(u).pn * tstepB + (size_t)(u).k0 * kstep)
    Unit cur, nxt; int ui = 0;
    if (!S.next(0, cur)) return;
    f32x4 acc[2][2][4][2];
#pragma unroll
    for (int a = 0; a < 2; ++a)
#pragma unroll
        for (int b = 0; b < 2; ++b)
#pragma unroll
            for (int m = 0; m < 4; ++m)
#pragma unroll
                for (int n = 0; n < 2; ++n) acc[a][b][m][n] = (f32x4){0.f, 0.f, 0.f, 0.f};
    bf16x8 At[4][2], B0[2][2], B1[2][2];
    const char* cA = PG8_UA(cur); const char* cB = PG8_UB(cur);
    S.a_ready(cur);
    PG8_STAGE(PG8_SB(0, 0), cB, voffB); PG8_STAGE(PG8_SB(0, 1), cB + hstepB, voffB); PG8_STAGE(PG8_SA(0, 0), cA, voffA); PG8_STAGE(PG8_SA(0, 1), cA + hstepA, voffA);
    if (wr == 1) PG8_BAR;
    PG8_WAIT_V(2); PG8_BAR;
    PG8_STAGE(PG8_SB(1, 0), cB + kstep, voffB); PG8_STAGE(PG8_SA(1, 0), cA + kstep, voffA); PG8_STAGE(PG8_SB(1, 1), cB + hstepB + kstep, voffB);
    PG8_WAIT_V(6); PG8_BAR;
    for (;;) {
        const bool has_next = S.next(ui + 1, nxt);
        const char* nA = has_next ? PG8_UA(nxt) : cA; const char* nB = has_next ? PG8_UB(nxt) : cB;
        const int nt = cur.nt;
        for (int t = 0; t < nt; t += 2) {
            const bool last = (t == nt - 2);
            const char* a1 = cA + (size_t)(t + 1) * kstep;
            const char* a2 = last ? nA : cA + (size_t)(t + 2) * kstep; const char* b2 = last ? nB : cB + (size_t)(t + 2) * kstep;
            const char* a3 = a2 + kstep; const char* b3 = b2 + kstep;
            if (last && has_next) S.a_ready(nxt);
            PG8_LDB(B0, 0, 0); PG8_LDB(B1, 0, 1); PG8_SCHED; PG8_LDA(At, 0, 0); PG8_STAGE(PG8_SA(1, 1), a1 + hstepA, voffA);
            PG8_WAIT_V(8); PG8_WAIT_L(0); PG8_BAR; PG8_MMA(0, 0, At, B0); PG8_MMA(0, 1, At, B1); PG8_BAR; PG8_SCHED;
            PG8_LDA(At, 0, 1); PG8_STAGE(PG8_SB(0, 0), b2, voffB); PG8_STAGE(PG8_SB(0, 1), b2 + hstepB, voffB); PG8_STAGE(PG8_SA(0, 0), a2, voffA);
            PG8_WAIT_V(8); PG8_WAIT_L(0); PG8_BAR; PG8_MMA(1, 0, At, B0); PG8_MMA(1, 1, At, B1); PG8_BAR; PG8_SCHED;
            PG8_LDB(B0, 1, 0); PG8_LDB(B1, 1, 1); PG8_SCHED; PG8_LDA(At, 1, 0); PG8_STAGE(PG8_SA(0, 1), a2 + hstepA, voffA);
            PG8_WAIT_V(8); PG8_WAIT_L(0); PG8_BAR; PG8_MMA(0, 0, At, B0); PG8_MMA(0, 1, At, B1); PG8_BAR; PG8_SCHED;
            PG8_LDA(At, 1, 1); PG8_STAGE(PG8_SB(1, 0), b3, voffB); PG8_STAGE(PG8_SB(1, 1), b3 + hstepB, voffB); PG8_STAGE(PG8_SA(1, 0), a3, voffA);
            PG8_WAIT_V(8); PG8_WAIT_L(0); PG8_BAR; PG8_MMA(1, 0, At, B0); PG8_MMA(1, 1, At, B1); PG8_BAR; PG8_SCHED;
        }
        if constexpr (ALIGN_EPI) { if (wr == 0) PG8_BAR; }
        E(acc, cur, wr, wc, fr, fq); S.done(cur);
        if (!has_next) break;
#pragma unroll
        for (int a = 0; a < 2; ++a)
#pragma unroll
            for (int b = 0; b < 2; ++b)
#pragma unroll
                for (int m = 0; m < 4; ++m)
#pragma unroll
                    for (int n = 0; n < 2; ++n) acc[a][b][m][n] = (f32x4){0.f, 0.f, 0.f, 0.f};
        cur = nxt; cA = nA; cB = nB; ++ui;
        if constexpr (ALIGN_EPI) { if (wr == 1) PG8_BAR; }
    }
    PG8_WAIT_V(0);
    if constexpr (!ALIGN_EPI) { if (wr == 0) PG8_BAR; }
    PG8_BAR;
#undef PG8_SA
#undef PG8_SB
#undef PG8_STAGE
#undef PG8_LDA
#undef PG8_LDB
#undef PG8_MMA
#undef PG8_WAIT_V
#undef PG8_WAIT_L
#undef PG8_BAR
#undef PG8_SCHED
#undef PG8_UA
#undef PG8_UB
}
}

#define XB_TMO      128
#define XB_XCNT(j)  (256  + 64 * (j))
#define XB_XSUB(j)  (1280 + 64 * (j))
#define XB_XGEN(j)  (2304 + 64 * (j))
#define XB_TOP      3328
#define XB_TOPGEN   3392
#define XCD_BAR_WORDS 3456
#define XB_SPIN_CAP (1u << 18)
__device__ __forceinline__ unsigned xb_ld(unsigned* p)              { return __hip_atomic_load(p, __ATOMIC_RELAXED, __HIP_MEMORY_SCOPE_AGENT); }
__device__ __forceinline__ unsigned xb_add(unsigned* p, unsigned v) { return __hip_atomic_fetch_add(p, v, __ATOMIC_RELAXED, __HIP_MEMORY_SCOPE_AGENT); }
__device__ __forceinline__ unsigned xb_xcc_id() { return (unsigned)__builtin_amdgcn_s_getreg((3 << 11) | 20) & 0xFu; }
#define XB_SPIN(cond, bar) do { unsigned _sp = 0; while (cond) { __builtin_amdgcn_s_sleep(1); \
    if ((++_sp & 255u) == 0u) { if (xb_ld(&(bar)[XB_TMO])) break; if (_sp > XB_SPIN_CAP) { atomicAdd(&(bar)[XB_TMO], 1u); break; } } } } while (0)
struct XcdBarrier { unsigned* bar; unsigned x; volatile LAS unsigned* st; };
__device__ __forceinline__ XcdBarrier xcd_barrier_post(unsigned* bar, volatile LAS unsigned* st) {
    XcdBarrier b; b.bar = bar; b.x = xb_xcc_id(); b.st = st;
    if (threadIdx.x == 0) { st[2] = xb_add(&bar[XB_XCNT(b.x)], 1u); st[3] = b.x; }
    return b;
}
__device__ __forceinline__ void xcd_barrier_complete(unsigned* bar, unsigned x, unsigned& nloc, unsigned& nx) {
    const unsigned G = gridDim.x * gridDim.y * gridDim.z;
    unsigned sum, cnt, mine, sp = 0u;
    for (;;) {
        sum = 0u; cnt = 0u; mine = 0u;
#pragma unroll
        for (unsigned j = 0; j < 16; ++j) { const unsigned c = xb_ld(&bar[XB_XCNT(j)]); sum += c; cnt += (c > 0u) ? 1u : 0u; mine = (j == x) ? c : mine; }
        if (sum == G) break;
        __builtin_amdgcn_s_sleep(1);
        if ((++sp & 255u) == 0u) { if (xb_ld(&bar[XB_TMO])) break; if (sp > XB_SPIN_CAP) { atomicAdd(&bar[XB_TMO], 1u); break; } }
    }
    nloc = mine > 0u ? mine : 1u; nx = cnt > 0u ? cnt : 1u;
}
__device__ __forceinline__ void xcd_barrier(const XcdBarrier& b) {
    asm volatile("s_waitcnt vmcnt(0)" ::: "memory");
    __syncthreads();
    if (threadIdx.x == 0) {
        unsigned* bar = b.bar;
        __builtin_amdgcn_s_waitcnt(0);
        unsigned nloc = b.st[0], nx = b.st[1];
        if (nloc == 0u) { xcd_barrier_complete(bar, b.x, nloc, nx); b.st[0] = nloc; b.st[1] = nx; }
        const unsigned old = xb_add(&bar[XB_XSUB(b.x)], 1u);
        const unsigned gen = old / nloc;
        if (old + 1u == (gen + 1u) * nloc) {
            __builtin_amdgcn_fence(__ATOMIC_RELEASE, "agent");
            asm volatile("s_waitcnt vmcnt(0)" ::: "memory");
            const unsigned og = xb_add(&bar[XB_TOP], 1u);
            const unsigned tg = og / nx;
            if (og + 1u == (tg + 1u) * nx) xb_add(&bar[XB_TOPGEN], 1u);
            else XB_SPIN(xb_ld(&bar[XB_TOPGEN]) == tg, bar);
            __builtin_amdgcn_fence(__ATOMIC_ACQUIRE, "agent");
            xb_add(&bar[XB_XGEN(b.x)], 1u);
            asm volatile("s_waitcnt vmcnt(0)" ::: "memory");
        } else {
            XB_SPIN(xb_ld(&bar[XB_XGEN(b.x)]) == gen, bar);
            __builtin_amdgcn_fence(__ATOMIC_ACQUIRE, "agent");
            asm volatile("s_waitcnt vmcnt(0)" ::: "memory");
        }
    }
    __syncthreads();
}

struct Params { const float* in[20]; float* out; unsigned char* ws; };
struct Frame {
    LAS unsigned char* lds;
    int tid, lane, wave, G, bid;
    const float *x_p, *x_s, *cache_k, *cache_v, *cache_ki, *state_pool, *c_p, *c_s, *g_mix, *g_ffn, *w_mod, *b_mod, *w_in, *w_o, *pool_w, *pool_scale, *w_up, *w_down, *g_final;
    const int* page_table;
    float* out; unsigned char* ws;
    float* MOD; bf16_t *SILU, *WIN, *WO, *WPOOL, *WUP, *WDN, *HB, *QB, *KB, *VB, *QIB, *KIB, *OB, *UB; float *WIF, *X; unsigned short* ILG;
};
__device__ __forceinline__ int brow_of(int r) { return r < MP ? (r >> 12) : NBATCH + ((r - MP) >> 2); }

struct EpiProj {
    static constexpr bool PERM = true;
    bf16_t *QB, *KB, *VB, *QIB, *KIB; float* WIF; float* out;
    __device__ __forceinline__ void operator()(const f32x4 (&acc)[2][2][4][2], const pg8::Unit& u, int wr, int wc, int fr, int fq) const {
        const int pn = u.pn;
#pragma unroll
        for (int ai = 0; ai < 2; ++ai)
#pragma unroll
            for (int m = 0; m < 4; ++m) {
                const int row = u.pm * 256 + ai * 128 + wr * 64 + m * 16 + fr;
#pragma unroll
                for (int bj = 0; bj < 2; ++bj) {
                    const int cl = bj * 128 + wc * 32 + 8 * fq;
                    const f32x4 v0 = acc[ai][bj][m][0], v1 = acc[ai][bj][m][1];
                    const bf16x8 pk = pack8(v0, v1);
                    if (pn < 4) { *(bf16x8*)(QB + (size_t)row * D + pn * 256 + cl) = pk; }
                    else if (pn == 4 || pn == 5) {
                        bf16_t* B = pn == 4 ? KB : VB; *(bf16x8*)(B + (size_t)row * KVW + cl) = pk;
                        float* o = out + (row < MP ? (pn == 4 ? O_KP : O_VP) + (size_t)row * KVW : (pn == 4 ? O_KS : O_VS) + (size_t)(row - MP) * KVW) + cl;
                        *(f32x4*)o = v0; *(f32x4*)(o + 4) = v1;
                    } else if (pn < 8) { *(bf16x8*)(QIB + (size_t)row * QIW + (pn - 6) * 256 + cl) = pk; }
                    else {
                        if (cl < 64) { *(bf16x8*)(KIB + (size_t)(row >> 5) * (32 * IDD) + ((cl >> 3) * 32 + (row & 31)) * 8) = pk;
                            float* o = out + (row < MP ? O_KIP + (size_t)row * IDD : O_KIS + (size_t)(row - MP) * IDD) + cl; *(f32x4*)o = v0; *(f32x4*)(o + 4) = v1; }
                        else if (cl == 64) { float* o = WIF + (size_t)row * 8; *(f32x4*)o = v0; *(f32x4*)(o + 4) = v1; }
                    }
                }
            }
    }
};
struct EpiUp {
    static constexpr bool PERM = true;
    bf16_t* UB;
    __device__ __forceinline__ void operator()(const f32x4 (&acc)[2][2][4][2], const pg8::Unit& u, int wr, int wc, int fr, int fq) const {
#pragma unroll
        for (int ai = 0; ai < 2; ++ai)
#pragma unroll
            for (int m = 0; m < 4; ++m) {
                const int row = u.pm * 256 + ai * 128 + wr * 64 + m * 16 + fr;
#pragma unroll
                for (int bj = 0; bj < 2; ++bj) {
                    const int cl = u.pn * 256 + bj * 128 + wc * 32 + 8 * fq;
                    f32x4 v0 = acc[ai][bj][m][0], v1 = acc[ai][bj][m][1];
#pragma unroll
                    for (int j = 0; j < 4; ++j) { const float a = fmaxf(v0[j], 0.f), b = fmaxf(v1[j], 0.f); v0[j] = a * a; v1[j] = b * b; }
                    *(bf16x8*)(UB + (size_t)row * DFF + cl) = pack8(v0, v1);
                }
            }
    }
};
struct EpiRes {
    static constexpr bool PERM = false;
    const float *xin_p, *xin_s;
    float* X; const float* gate;
    const float* cscale;
    __device__ __forceinline__ void operator()(const f32x4 (&acc)[2][2][4][2], const pg8::Unit& u, int wr, int wc, int fr, int fq) const {
#pragma unroll
        for (int ai = 0; ai < 2; ++ai)
#pragma unroll
            for (int m = 0; m < 4; ++m) {
                const int row = u.pm * 256 + ai * 128 + wr * 64 + m * 16 + fr;
                const float* xi = row < MP ? xin_p + (size_t)row * D : xin_s + (size_t)(row - MP) * D;
                const float* gr = gate + (size_t)brow_of(row) * NMOD;
#pragma unroll
                for (int bj = 0; bj < 2; ++bj)
#pragma unroll
                    for (int n = 0; n < 2; ++n) {
                        const int c = u.pn * 256 + bj * 128 + wc * 32 + 16 * n + 4 * fq;
                        f32x4 a = acc[ai][bj][m][n];
                        if (cscale) a = a * *(const f32x4*)(cscale + c);
                        if (u.atomic) { const f32x4 o = *(const f32x4*)(gr + c) * a; float* xo = X + (size_t)row * D + c;
#pragma unroll
                            for (int e = 0; e < 4; ++e) (void)__hip_atomic_fetch_add(xo + e, o[e], __ATOMIC_RELAXED, __HIP_MEMORY_SCOPE_AGENT); }
                        else { const f32x4 o = *(const f32x4*)(xi + c) + *(const f32x4*)(gr + c) * a; *(f32x4*)(X + (size_t)row * D + c) = o; }
                    }
            }
    }
};

__device__ __forceinline__ float wave_sum(float v) {
#pragma unroll
    for (int o = 1; o < 64; o <<= 1) v += __shfl_xor(v, o);
    return v;
}
template <int CTRL> __device__ __forceinline__ unsigned dpp_u(unsigned v) { return (unsigned)__builtin_amdgcn_update_dpp(0, (int)v, CTRL, 0xf, 0xf, true); }
__device__ __forceinline__ unsigned wave_sum_u(unsigned v) {
    v += dpp_u<0xB1>(v); v += dpp_u<0x4E>(v); v += dpp_u<0x141>(v); v += dpp_u<0x140>(v);
    return (unsigned)__builtin_amdgcn_readlane((int)v, 0) + (unsigned)__builtin_amdgcn_readlane((int)v, 16) + (unsigned)__builtin_amdgcn_readlane((int)v, 32) + (unsigned)__builtin_amdgcn_readlane((int)v, 48);
}
__device__ __forceinline__ unsigned wave_max_u(unsigned v) {
    unsigned t;
    t = dpp_u<0xB1>(v); v = v > t ? v : t; t = dpp_u<0x4E>(v); v = v > t ? v : t; t = dpp_u<0x141>(v); v = v > t ? v : t; t = dpp_u<0x140>(v); v = v > t ? v : t;
    const unsigned a = (unsigned)__builtin_amdgcn_readlane((int)v, 0), b = (unsigned)__builtin_amdgcn_readlane((int)v, 16), c = (unsigned)__builtin_amdgcn_readlane((int)v, 32), d = (unsigned)__builtin_amdgcn_readlane((int)v, 48);
    const unsigned ab = a > b ? a : b, cd = c > d ? c : d; return ab > cd ? ab : cd;
}

__device__ __forceinline__ void transpose_item(const float* W, int N, bf16_t* WT, int ldo, int row_off, LAS float* scr, int kb, int nb, int lane) {
    const int k0 = 64 * kb, n0 = 32 * nb;
    const int n = n0 + 4 * (lane & 7);
    f32x4 v[8];
#pragma unroll
    for (int i = 0; i < 8; ++i) { const int kk = 8 * i + (lane >> 3); v[i] = (n < N) ? *(const f32x4*)(W + (size_t)(k0 + kk) * N + n) : (f32x4){0.f, 0.f, 0.f, 0.f}; }
#pragma unroll
    for (int i = 0; i < 8; ++i) { const int kk = 8 * i + (lane >> 3); LAS float* d = scr + kk * 33 + 4 * (lane & 7); d[0] = v[i][0]; d[1] = v[i][1]; d[2] = v[i][2]; d[3] = v[i][3]; }
    LDS_WAIT(); asm volatile("" ::: "memory");
    const int c = lane & 7;
#pragma unroll
    for (int j = 0; j < 4; ++j) { const int nn = (lane >> 3) + 8 * j; const LAS float* s = scr + (8 * c) * 33 + nn;
        u32x4 o; o.x = pk2(s[0 * 33], s[1 * 33]); o.y = pk2(s[2 * 33], s[3 * 33]); o.z = pk2(s[4 * 33], s[5 * 33]); o.w = pk2(s[6 * 33], s[7 * 33]);
        *(u32x4*)(WT + (size_t)(row_off + n0 + nn) * ldo + k0 + 8 * c) = o; }
    LDS_WAIT(); asm volatile("" ::: "memory");
}

constexpr int CW_SILU = 8192;
__device__ __forceinline__ void p0_mod_task(Frame& F, int task, unsigned* flag) {
    const int col = F.lane & 15, kq = F.lane >> 4;
    const int l = task / (NMOD / 16), n0 = (task % (NMOD / 16)) * 16;
    const float* W = F.w_mod + (size_t)l * D * NMOD + n0 + col;
    f32x4 acc[9];
#pragma unroll
    for (int i = 0; i < 9; ++i) acc[i] = (f32x4){0.f, 0.f, 0.f, 0.f};
    { unsigned sp = 0; while (__hip_atomic_load(flag, __ATOMIC_RELAXED, __HIP_MEMORY_SCOPE_AGENT) < 144u) { __builtin_amdgcn_s_sleep(4); if (++sp > (1u << 22)) break; }
      __builtin_amdgcn_fence(__ATOMIC_ACQUIRE, "agent"); asm volatile("s_waitcnt vmcnt(0)" ::: "memory"); }
#pragma unroll 8
    for (int ks = 0; ks < D / 32; ++ks) {
        const int k0 = 32 * ks + 8 * kq;
        float f[8];
#pragma unroll
        for (int j = 0; j < 8; ++j) f[j] = W[(size_t)(k0 + j) * NMOD];
        u32x4 bw; bw.x = pk2(f[0], f[1]); bw.y = pk2(f[2], f[3]); bw.z = pk2(f[4], f[5]); bw.w = pk2(f[6], f[7]);
        const bf16x8 bfr = __builtin_bit_cast(bf16x8, bw);
#pragma unroll
        for (int mt = 0; mt < 9; ++mt) {
            const bf16x8 a = *(const bf16x8*)(F.SILU + (size_t)(16 * mt + col) * D + k0);
            acc[mt] = __builtin_amdgcn_mfma_f32_16x16x32_bf16(a, bfr, acc[mt], 0, 0, 0);
        }
    }
    const float bias = F.b_mod[(size_t)l * NMOD + n0 + col];
#pragma unroll
    for (int mt = 0; mt < 9; ++mt)
#pragma unroll
        for (int r = 0; r < 4; ++r) { const int row = 16 * mt + 4 * kq + r; if (row < NBROW) F.MOD[((size_t)l * NBROW + row) * NMOD + n0 + col] = acc[mt][r] + bias; }
}
__device__ __forceinline__ void p0(Frame& F) {
    LAS float* scr = (LAS float*)(F.lds + F.wave * 16384);
    unsigned* flag = (unsigned*)(F.ws + WS_CTL) + CW_SILU;
    const int gw = F.bid * NWAVES + F.wave, NGW = F.G * NWAVES;
    constexpr int I_IN = (D / 64) * (NPROJ / 32), I_O = (D / 64) * (D / 32), I_P = 4 * (256 / 64) * (256 / 32), I_UP = (D / 64) * (DFF / 32), I_DN = (DFF / 64) * (D / 32);
    constexpr int N_SILU = 144, N_MOD = 2 * (NMOD / 16);
    constexpr int NIT = N_SILU + N_MOD + I_IN + I_O + I_P + 2 * I_UP + 2 * I_DN;
    for (int it = gw; it < NIT; it += NGW) {
        int r = it;
        if (r < N_SILU) {
            const float* c = r < NBATCH ? F.c_p + (size_t)r * D : F.c_s + (size_t)(r - NBATCH) * D;
#pragma unroll
            for (int j = 0; j < 4; ++j) {
                f32x4 v = {0.f, 0.f, 0.f, 0.f};
                if (r < NBROW) { v = *(const f32x4*)(c + 4 * F.lane + 256 * j);
#pragma unroll
                    for (int e = 0; e < 4; ++e) v[e] = v[e] * __builtin_amdgcn_rcpf(1.f + __expf(-v[e])); }
                u32x2 o; o.x = pk2(v[0], v[1]); o.y = pk2(v[2], v[3]);
                *(u32x2*)(F.SILU + (size_t)r * D + 4 * F.lane + 256 * j) = o;
            }
            asm volatile("s_waitcnt vmcnt(0)" ::: "memory");
            if (F.lane == 0) { __builtin_amdgcn_fence(__ATOMIC_RELEASE, "agent"); asm volatile("s_waitcnt vmcnt(0)" ::: "memory"); (void)__hip_atomic_fetch_add(flag, 1u, __ATOMIC_RELAXED, __HIP_MEMORY_SCOPE_AGENT); }
            continue;
        } r -= N_SILU;
        if (r < N_MOD) { p0_mod_task(F, r, flag); continue; } r -= N_MOD;
        if (r < I_IN) { transpose_item(F.w_in, DPROJ, F.WIN, D, 0, scr, r / (NPROJ / 32), r % (NPROJ / 32), F.lane); continue; } r -= I_IN;
        if (r < I_O) { transpose_item(F.w_o, D, F.WO, D, 0, scr, r / (D / 32), r % (D / 32), F.lane); continue; } r -= I_O;
        if (r < I_P) { const int g = r / 32, q = r % 32; transpose_item(F.pool_w + (size_t)g * 65536, 256, F.WPOOL, 256, g * 256, scr, q / 8, q % 8, F.lane); continue; } r -= I_P;
        if (r < 2 * I_UP) { const int l = r / I_UP, q = r % I_UP; transpose_item(F.w_up + (size_t)l * D * DFF, DFF, F.WUP + (size_t)l * D * DFF, D, 0, scr, q / (DFF / 32), q % (DFF / 32), F.lane); continue; } r -= 2 * I_UP;
        { const int l = r / I_DN, q = r % I_DN; transpose_item(F.w_down + (size_t)l * D * DFF, D, F.WDN + (size_t)l * D * DFF, DFF, 0, scr, q / (D / 32), q % (D / 32), F.lane); }
    }
}

template <int MODE>
__device__ __forceinline__ void rowpass(Frame& F, const float* src_p, const float* src_s, const float* gain, const float* mod_l, int sh_chunk, int sc_chunk, bf16_t* dst) {
    const int gw = F.bid * NWAVES + F.wave, NGW = F.G * NWAVES;
    for (int r = gw; r < MT; r += NGW) {
        const float* xr = r < MP ? src_p + (size_t)r * D : src_s + (size_t)(r - MP) * D;
        f32x4 v[4]; float s = 0.f;
#pragma unroll
        for (int j = 0; j < 4; ++j) { v[j] = *(const f32x4*)(xr + 4 * F.lane + 256 * j); s += (v[j].x * v[j].x + v[j].y * v[j].y) + (v[j].z * v[j].z + v[j].w * v[j].w); }
        const float rstd = __builtin_amdgcn_rsqf(wave_sum(s) * (1.f / D) + RMS_EPS);
        if (MODE == 2) {
            float* o = r < MP ? F.out + O_YP + (size_t)r * D : F.out + O_YS + (size_t)(r - MP) * D;
#pragma unroll
            for (int j = 0; j < 4; ++j) { const int c = 4 * F.lane + 256 * j; *(f32x4*)(o + c) = v[j] * rstd * *(const f32x4*)(gain + c); }
        } else {
            const float* mr = mod_l + (size_t)brow_of(r) * NMOD;
            float* po = nullptr;
            if (MODE == 1) {
                if (r < MP) { const int t = r & (SEQ - 1); if (t >= SEQ - POOLST) po = F.out + O_POOLP + ((size_t)(r >> 12) * POOLST + (t - (SEQ - POOLST))) * D; }
                else { const int q = r - MP; po = F.out + O_POOLS + ((size_t)(q >> 2) * POOLST + (POOLST - DECS) + (q & 3)) * D; }
            }
#pragma unroll
            for (int j = 0; j < 4; ++j) { const int c = 4 * F.lane + 256 * j;
                const f32x4 h = v[j] * rstd * *(const f32x4*)(gain + c) * (*(const f32x4*)(mr + sc_chunk * D + c) + 1.0f) + *(const f32x4*)(mr + sh_chunk * D + c);
                u32x2 o; o.x = pk2(h[0], h[1]); o.y = pk2(h[2], h[3]);
                *(u32x2*)(dst + (size_t)r * D + c) = o;
                if (MODE == 3 && r >= MP) *(f32x4*)(F.X + (size_t)r * D + c) = v[j];
                if (MODE == 1 && po) *(f32x4*)(po + c) = h; }
        }
    }
    if (MODE == 1) {
        for (int it = gw; it < DECB * (POOLST - DECS); it += NGW) { const int seq = it / (POOLST - DECS), i = it % (POOLST - DECS);
            const float* s = F.state_pool + ((size_t)seq * POOLST + i + DECS) * D; float* o = F.out + O_POOLS + ((size_t)seq * POOLST + i) * D;
#pragma unroll
            for (int j = 0; j < 4; ++j) *(f32x4*)(o + 4 * F.lane + 256 * j) = *(const f32x4*)(s + 4 * F.lane + 256 * j); }
    }
}

__device__ __forceinline__ void poolpass(Frame& F, const bf16_t* H, bf16_t* PB) {
    const int gt = F.bid * NTHREADS + F.tid, NGT = F.G * NTHREADS;
    for (int it = gt; it < MT * 128; it += NGT) {
        const int r = it >> 7, c8 = it & 127, g = c8 >> 5, w = 2 << g;
        float s[8];
#pragma unroll
        for (int e = 0; e < 8; ++e) s[e] = 0.f;
        const u32x4 hv = *(const u32x4*)(H + (size_t)r * D + 8 * c8);
        float cnt;
        if (r < MP) {
            const int t = r & (SEQ - 1); const int n = (t + 1) < w ? (t + 1) : w; cnt = (float)n;
            for (int j = 0; j < n; ++j) { const u32x4 a = j == 0 ? hv : *(const u32x4*)(H + (size_t)(r - j) * D + 8 * c8);
                s[0] += bflo(a.x); s[1] += bfhi(a.x); s[2] += bflo(a.y); s[3] += bfhi(a.y); s[4] += bflo(a.z); s[5] += bfhi(a.z); s[6] += bflo(a.w); s[7] += bfhi(a.w); }
        } else {
            const int q = r - MP, seq = q >> 2, t = q & 3; cnt = (float)w;
            for (int j = 0; j < w; ++j) { const int e = t - j;
                if (e >= 0) { const u32x4 a = j == 0 ? hv : *(const u32x4*)(H + (size_t)(r - j) * D + 8 * c8);
                    s[0] += bflo(a.x); s[1] += bfhi(a.x); s[2] += bflo(a.y); s[3] += bfhi(a.y); s[4] += bflo(a.z); s[5] += bfhi(a.z); s[6] += bflo(a.w); s[7] += bfhi(a.w); }
                else { const float* p = F.state_pool + ((size_t)seq * POOLST + POOLST + e) * D + 8 * c8; const f32x4 a = *(const f32x4*)p, b = *(const f32x4*)(p + 4);
                    s[0] += a[0]; s[1] += a[1]; s[2] += a[2]; s[3] += a[3]; s[4] += b[0]; s[5] += b[1]; s[6] += b[2]; s[7] += b[3]; } }
        }
        const float ic = __builtin_amdgcn_rcpf(cnt);
        u32x4 o; o.x = pk2(s[0] * ic - bflo(hv.x), s[1] * ic - bfhi(hv.x)); o.y = pk2(s[2] * ic - bflo(hv.y), s[3] * ic - bfhi(hv.y));
        o.z = pk2(s[4] * ic - bflo(hv.z), s[5] * ic - bfhi(hv.z)); o.w = pk2(s[6] * ic - bflo(hv.w), s[7] * ic - bfhi(hv.w));
        *(u32x4*)(PB + (size_t)r * D + 8 * c8) = o;
    }
}

__device__ __forceinline__ unsigned okey(float f) { const unsigned u = __float_as_uint(f); return (u & 0x80000000u) ? ~u : (u | 0x80000000u); }
__device__ __forceinline__ bf16x8 ld8_bf(const bf16_t* p) { return *(const bf16x8*)p; }
__device__ __forceinline__ bf16x8 ld8_f32(const float* p) { const f32x4 a = *(const f32x4*)p, b = *(const f32x4*)(p + 4); return pack8(a, b); }
__device__ __forceinline__ s16x4 vtr(const LAS unsigned char* p) { typedef short v4i16_t __attribute__((ext_vector_type(4))); return __builtin_bit_cast(s16x4, __builtin_amdgcn_ds_read_tr16_b64_v4i16((LAS v4i16_t*)p)); }

template <bool F32SRC>
__device__ __forceinline__ void attn_query(Frame& F, int lane, const LAS unsigned short* IL, LAS unsigned char* vst, int nsel, int qrow, int b, const int* pt, int seq, int gsel) {
    constexpr int NB = F32SRC ? 2 : 4;
    asm volatile("" : "+v"(lane));
    const int col = lane & 15, kq = lane >> 4;
    bf16x8 Bq[4];
#pragma unroll
    for (int c = 0; c < 4; ++c) { bf16x8 qv = (bf16x8){0, 0, 0, 0, 0, 0, 0, 0}; if (col < 4) qv = ld8_bf(F.QB + (size_t)qrow * D + (gsel * 4 + col) * HD + 32 * c + 8 * kq); Bq[c] = qv; }
    const int lrow = lane >> 2, lpc = lane & 3;
    const int psrc = (4 * col + kq) * 4;
    const char* kbase = (const char*)(F.KB + (size_t)b * SEQ * KVW + gsel * HD) + lpc * 16;
    unsigned koff[16]; const float* kptr[16];
#pragma unroll
    for (int t = 0; t < 16; ++t) {
        if (F32SRC) { const int key = IL[16 * t + col]; kptr[t] = (key < PAST ? F.cache_k + ((size_t)pt[key >> 7] * PAGE + (key & (PAGE - 1))) * KVW : F.out + O_KS + (size_t)(seq * DECS + key - PAST) * KVW) + gsel * HD + 8 * kq; }
        else { const int key = IL[16 * t + lrow]; koff[t] = (unsigned)key * (KVW * 2); } }
    bf16x8 kbuf[NB][4];
#define ATT_LOADU(u) do { _Pragma("unroll") for (int c_ = 0; c_ < 4; ++c_) \
        kbuf[(u) % NB][c_] = F32SRC ? ld8_f32(kptr[u] + 32 * c_) : ld8_bf((const bf16_t*)(kbase + koff[u] + c_ * 64)); } while (0)
#pragma unroll
    for (int u = 0; u < NB; ++u) ATT_LOADU(u);
    f32x4 S[16];
#pragma unroll
    for (int u = 0; u < 16; ++u) {
        f32x4 a = (f32x4){0.f, 0.f, 0.f, 0.f};
#pragma unroll
        for (int c = 0; c < 4; ++c) {
            bf16x8 kf = kbuf[u % NB][c];
            if (!F32SRC) { u32x4 w = __builtin_bit_cast(u32x4, kf);
                w.x = (unsigned)__builtin_amdgcn_ds_bpermute(psrc, (int)w.x); w.y = (unsigned)__builtin_amdgcn_ds_bpermute(psrc, (int)w.y);
                w.z = (unsigned)__builtin_amdgcn_ds_bpermute(psrc, (int)w.z); w.w = (unsigned)__builtin_amdgcn_ds_bpermute(psrc, (int)w.w);
                kf = __builtin_bit_cast(bf16x8, w); }
            a = __builtin_amdgcn_mfma_f32_16x16x32_bf16(kf, Bq[c], a, 0, 0, 0);
        }
        S[u] = a;
        if (u + NB < 16) ATT_LOADU(u + NB);
    }
#undef ATT_LOADU
    u32x4 R[2][4];
    const char* vbase = (const char*)(F.VB + (size_t)b * SEQ * KVW + gsel * HD) + (lane & 15) * 16;
#define ATT_LOADV(hb, blk) do { _Pragma("unroll") for (int ld_ = 0; ld_ < 4; ++ld_) { const int key_ = IL[32 * (blk) + 16 * (hb) + 4 * ld_ + (lane >> 4)]; \
        if (F32SRC) R[hb][ld_] = __builtin_bit_cast(u32x4, ld8_f32((key_ < PAST ? F.cache_v + ((size_t)pt[key_ >> 7] * PAGE + (key_ & (PAGE - 1))) * KVW : F.out + O_VS + (size_t)(seq * DECS + key_ - PAST) * KVW) + gsel * HD + 8 * (lane & 15))); \
        else R[hb][ld_] = *(const u32x4*)(vbase + (unsigned)key_ * (KVW * 2)); } } while (0)
    ATT_LOADV(0, 0); ATT_LOADV(1, 0);
    float mxs = -INFINITY;
#pragma unroll
    for (int t = 0; t < 16; ++t)
#pragma unroll
        for (int r = 0; r < 4; ++r) { const int p = 16 * t + 4 * kq + r; if (p >= nsel) S[t][r] = -INFINITY; mxs = fmaxf(mxs, S[t][r]); }
    mxs = fmaxf(mxs, __shfl_xor(mxs, 16)); mxs = fmaxf(mxs, __shfl_xor(mxs, 32));
    const float c2 = 0.08838834764831845f * 1.4426950408889634f;
    float lsum = 0.f;
#pragma unroll
    for (int t = 0; t < 16; ++t)
#pragma unroll
        for (int r = 0; r < 4; ++r) { const float p = __builtin_amdgcn_exp2f((S[t][r] - mxs) * c2); S[t][r] = p; lsum += p; }
    lsum += __shfl_xor(lsum, 16); lsum += __shfl_xor(lsum, 32);
    bf16x8 PA[8];
#pragma unroll
    for (int i = 0; i < 8; ++i) PA[i] = pack8(S[2 * i], S[2 * i + 1]);
    f32x4 O[8];
#pragma unroll
    for (int dt = 0; dt < 8; ++dt) O[dt] = (f32x4){0.f, 0.f, 0.f, 0.f};
    const int q_ = (lane & 15) >> 2, p_ = lane & 3;
    const int s0 = 4 * kq + q_;
#pragma unroll
    for (int i = 0; i < 8; ++i) {
#pragma unroll
        for (int hb = 0; hb < 2; ++hb) {
#pragma unroll
            for (int ld = 0; ld < 4; ++ld) { const int slot = 16 * hb + 4 * ld + (lane >> 4), ch = lane & 15;
                *(LAS u32x4*)(vst + slot * 256 + ((ch ^ ((slot & 7) << 1)) << 4)) = R[hb][ld]; }
            if (i + 1 < 8) { if (hb == 0) ATT_LOADV(0, i + 1); else ATT_LOADV(1, i + 1); }
        }
        asm volatile("" ::: "memory");
#pragma unroll
        for (int dt = 0; dt < 8; ++dt) {
            const int ch = dt * 2 + (p_ >> 1);
            const LAS unsigned char* a0 = vst + s0 * 256 + ((ch ^ ((s0 & 7) << 1)) << 4) + (p_ & 1) * 8;
            const s16x4 lo = vtr(a0), hi = vtr(a0 + 16 * 256);
            const bf16x8 bv = (bf16x8){lo[0], lo[1], lo[2], lo[3], hi[0], hi[1], hi[2], hi[3]};
            O[dt] = __builtin_amdgcn_mfma_f32_16x16x32_bf16(PA[i], bv, O[dt], 0, 0, 0);
        }
        asm volatile("" ::: "memory");
    }
#undef ATT_LOADV
    float inv[4];
#pragma unroll
    for (int h = 0; h < 4; ++h) inv[h] = __builtin_amdgcn_rcpf(__shfl(lsum, h));
    if (kq == 0) {
        bf16_t* ob = F.OB + (size_t)qrow * D + gsel * 4 * HD;
#pragma unroll
        for (int dt = 0; dt < 8; ++dt)
#pragma unroll
            for (int r = 0; r < 4; ++r) ob[r * HD + 16 * dt + col] = (bf16_t)(pk2(O[dt][r] * inv[r], 0.f) & 0xffffu);
    }
}

template <bool SAMPLE>
__device__ __forceinline__ void dsa_item(Frame& F, int item) {
    constexpr int NQ = SAMPLE ? 4 : 8, NG = SAMPLE ? 1 : 2, NREG = SAMPLE ? 33 : 64;
    int lane = F.lane; asm volatile("" : "+v"(lane));
    const int w = F.wave;
    LAS float* SC = (LAS float*)F.lds;
    LAS unsigned short* IDXL = (LAS unsigned short*)(F.lds + IDXL_OFF);
    const int seq = item;
    const int b = SAMPLE ? seq : (item & 3), t0 = SAMPLE ? PAST : (item >> 2) * 8;
    const int row0 = SAMPLE ? MP + seq * DECS : b * SEQ + t0;
    const int* pt = F.page_table + (SAMPLE ? seq * PAGES_PER_SEQ : 0);
    {
        const int r = lane & 31, hk = lane >> 5, hi = hk;
        const int q4 = (r >> 4) + 2 * ((r >> 2) & 1), head = (r & 3) + 4 * ((r >> 3) & 1);
        bf16x8 afr[NG][4]; float wiA[NG][8], wiB[NG][8];
        const float cs = 0.125f * 0.35355339059327373f;
#pragma unroll
        for (int G = 0; G < NG; ++G) {
#pragma unroll
            for (int c = 0; c < 4; ++c) afr[G][c] = ld8_bf(F.QIB + (size_t)(row0 + 4 * G + q4) * QIW + head * IDD + 16 * c + 8 * hk);
            const float* wa = F.WIF + (size_t)(row0 + 4 * G + 2 * hi) * 8;
#pragma unroll
            for (int h = 0; h < 8; ++h) { wiA[G][h] = wa[h] * cs; wiB[G][h] = wa[8 + h] * cs; }
        }
        const int nkt = SAMPLE ? 65 : (t0 + 8 + 31) / 32;
        auto load_tile = [&](bf16x8 (&fr)[4], int kt) {
            if (SAMPLE) {
                const int s_ = 32 * kt + r, sc = s_ < PAST + DECS - 1 ? s_ : PAST + DECS - 1;
                const int page = pt[kt < PAST / 32 ? (kt >> 2) : 0];
                const float* kp = kt < PAST / 32 ? F.cache_ki + ((size_t)page * PAGE + (sc & (PAGE - 1))) * IDD : F.out + O_KIS + (size_t)(seq * DECS + sc - PAST) * IDD;
#pragma unroll
                for (int c = 0; c < 4; ++c) fr[c] = ld8_f32(kp + 16 * c + 8 * hk);
            } else {
                const bf16_t* kp = F.KIB + ((size_t)(b * SEQ) / 32 + kt) * (32 * IDD) + (hk * 32 + r) * 8;
#pragma unroll
                for (int c = 0; c < 4; ++c) fr[c] = ld8_bf(kp + c * (2 * 32 * 8));
            }
        };
        auto do_tile = [&](const bf16x8 (&fr)[4], int kt) {
            const int s_ = 32 * kt + r;
#pragma unroll
            for (int G = 0; G < NG; ++G) {
                f32x16 acc;
#pragma unroll
                for (int i = 0; i < 16; ++i) acc[i] = 0.f;
#pragma unroll
                for (int c = 0; c < 4; ++c) acc = __builtin_amdgcn_mfma_f32_32x32x16_bf16(afr[G][c], fr[c], acc, 0, 0, 0);
                float sA = 0.f, sB = 0.f;
#pragma unroll
                for (int h = 0; h < 8; ++h) { sA += __builtin_amdgcn_fmed3f(acc[h], 0.f, __builtin_inff()) * wiA[G][h]; sB += __builtin_amdgcn_fmed3f(acc[8 + h], 0.f, __builtin_inff()) * wiB[G][h]; }
                SC[(4 * G + 2 * hi) * 4096 + s_] = sA + 0.0f; SC[(4 * G + 2 * hi + 1) * 4096 + s_] = sB + 0.0f;
            }
        };
        bf16x8 f0[4], f1[4];
        int kt = w;
        if (kt < nkt) load_tile(f0, kt);
        for (; kt < nkt; kt += 2 * NWAVES) {
            if (kt + NWAVES < nkt) load_tile(f1, kt + NWAVES);
            do_tile(f0, kt);
            if (kt + NWAVES < nkt) { if (kt + 2 * NWAVES < nkt) load_tile(f0, kt + 2 * NWAVES); do_tile(f1, kt + NWAVES); }
        }
    }
    __syncthreads();
    if (w < NQ) {
        asm volatile("" : "+v"(lane));
        const int qi = w;
        const int pos = t0 + qi, nvalid = pos + 1;
        const int nsel = nvalid < TOPK ? nvalid : TOPK;
        LAS unsigned short* IL = IDXL + w * 256;
        if (nvalid <= TOPK) {
#pragma unroll
            for (int i = 0; i < 4; ++i) { const int p = lane + 64 * i; IL[p] = (unsigned short)(p < nvalid ? p : 0); }
        } else {
            const LAS float* scl = SC + qi * 4096 + lane; asm volatile("" : "+v"(scl));
            constexpr int NCH = (NREG + 7) / 8;
            const int nch = (nvalid + 511) >> 9;
            unsigned u[NCH * 8]; unsigned mx = 0u;
#pragma unroll
            for (int c = 0; c < NCH; ++c) {
#pragma unroll
                for (int j = 0; j < 8; ++j) u[8 * c + j] = 0u;
                if (c < nch) {
#pragma unroll
                    for (int j = 0; j < 8; ++j) { const int s = 64 * (8 * c + j) + lane; const unsigned k = okey(scl[64 * (8 * c + j)]); u[8 * c + j] = s < nvalid ? k : 0u; mx = mx > u[8 * c + j] ? mx : u[8 * c + j]; }
                }
            }
            mx = wave_max_u(mx);
            LAS unsigned* hist = (LAS unsigned*)(F.lds + HIST_OFF) + w * 256;
            unsigned lo, wl, above = 0u, T, ngt;
            if (mx >= 0x80000000u + (1u << 25)) { lo = mx + 1u - (1u << 25); wl = 25u; } else { lo = 0u; wl = 32u; }
            for (;;) {
                const unsigned shift = wl > 8u ? wl - 8u : 0u;
                *(LAS u32x4*)(hist + 4 * lane) = (u32x4){0u, 0u, 0u, 0u};
#pragma unroll
                for (int c = 0; c < NCH; ++c) {
                    if (c < nch) {
#pragma unroll
                        for (int j = 0; j < 8; ++j) { const unsigned d = u[8 * c + j] - lo; const bool in = wl >= 32u ? true : (d >> wl) == 0u;
                            if (in) (void)__hip_atomic_fetch_add(hist + (d >> shift), 1u, __ATOMIC_RELAXED, __HIP_MEMORY_SCOPE_WORKGROUP); }
                    }
                }
                LDS_WAIT(); asm volatile("" ::: "memory");
                const u32x4 h4 = *(const LAS u32x4*)(hist + 4 * lane);
                const unsigned sl = (h4.x + h4.y) + (h4.z + h4.w);
                unsigned pre = sl;
#pragma unroll
                for (int o = 1; o < 64; o <<= 1) { const unsigned t = (unsigned)__shfl_up((int)pre, o); if (lane >= o) pre += t; }
                const unsigned total = (unsigned)__builtin_amdgcn_readlane((int)pre, 63);
                if (above + total < (unsigned)TOPK) { lo = 0u; wl = 32u; above = 0u; continue; }
                const unsigned suf = total - pre + sl;
                const unsigned long long bm = __ballot(above + suf >= (unsigned)TOPK);
                const int L = 63 - __builtin_clzll(bm);
                unsigned acc = above + suf - sl, bsel = 0u, csel = 0u, asel = 0u; bool fnd = false;
#pragma unroll
                for (int q = 3; q >= 0; --q) { const unsigned h = h4[q]; if (!fnd && acc + h >= (unsigned)TOPK) { bsel = 4u * (unsigned)lane + (unsigned)q; csel = h; asel = acc; fnd = true; } acc += h; }
                const unsigned bstar = (unsigned)__builtin_amdgcn_readlane((int)bsel, L), cnt_b = (unsigned)__builtin_amdgcn_readlane((int)csel, L);
                above = (unsigned)__builtin_amdgcn_readlane((int)asel, L);
                lo += bstar << shift;
                if (above + cnt_b == (unsigned)TOPK) { T = lo - 1u; ngt = (unsigned)TOPK; break; }
                if (shift == 0u) { T = lo; ngt = above; break; }
                wl = shift;
            }
            const unsigned need_eq = (unsigned)TOPK - ngt;
            unsigned base = 0u, eqb = 0u;
#pragma unroll
            for (int c = 0; c < NCH; ++c) {
                if (c < nch) {
#pragma unroll
                    for (int j = 0; j < 8; ++j) {
                        const int i = 8 * c + j;
                        const bool gt = u[i] > T, eq = u[i] == T;
                        const unsigned long long be = __ballot(eq);
                        const unsigned er = eqb + __builtin_amdgcn_mbcnt_hi((unsigned)(be >> 32), __builtin_amdgcn_mbcnt_lo((unsigned)be, 0u));
                        const bool sel = gt || (eq && er < need_eq);
                        const unsigned long long bs = __ballot(sel);
                        const unsigned p = base + __builtin_amdgcn_mbcnt_hi((unsigned)(bs >> 32), __builtin_amdgcn_mbcnt_lo((unsigned)bs, 0u));
                        if (sel && p < (unsigned)TOPK) IL[p] = (unsigned short)(64 * i + lane);
                        base += (unsigned)__popcll(bs); eqb += (unsigned)__popcll(be);
                    }
                }
            }
        }
        LDS_WAIT(); asm volatile("" ::: "memory");
        *(u32x2*)(F.ILG + (size_t)(row0 + qi) * TOPK + 4 * lane) = *(const LAS u32x2*)(IL + 4 * lane);
    }
    __syncthreads();
}
__device__ __forceinline__ void dsa_select_phase(Frame& F) {
    for (int k = F.bid; k < MP / 8; k += F.G) { const int kk = ((k >> 8) & 1) ? (k ^ 255) : k; dsa_item<false>(F, kk); }
    for (int s = F.bid; s < DECB; s += F.G) dsa_item<true>(F, s);
}
__device__ __forceinline__ void dsa_attn_phase(Frame& F, unsigned* bar, volatile LAS unsigned* st) {
    int lane = F.lane; asm volatile("" : "+v"(lane));
    const int w = F.wave;
    LAS unsigned short* IL = (LAS unsigned short*)(F.lds + IDXL_OFF) + w * 256;
    LAS unsigned char* vst = F.lds + w * 8192;
    if (F.tid == 0) {
        unsigned ok = 1u, nx = 0u, vx = 0u; const unsigned x = st[3];
        for (unsigned j = 0; j < 16; ++j) { const unsigned c = xb_ld(&bar[XB_XCNT(j)]); if (c) { if (c != 32u) ok = 0u; if (j < x) ++vx; ++nx; } }
        if (nx != 8u || F.G != 256) ok = 0u;
        st[4] = ok; st[5] = vx;
    }
    __syncthreads();
    const bool xok = st[4] != 0u;
    const int vx = xok ? (int)st[5] : (F.bid & 7), rk = xok ? (int)st[2] : (F.bid >> 3);
    if (F.G == 256) {
        const int b = vx >> 1, g = vx & 1, wv = rk * 8 + w;
        for (int i = 0; i < 16; ++i) {
            const int t = wv + 256 * i, qrow = b * SEQ + t;
            *(LAS u32x2*)(IL + 4 * lane) = *(const u32x2*)(F.ILG + (size_t)qrow * TOPK + 4 * lane);
            attn_query<false>(F, lane, IL, vst, t + 1 < TOPK ? t + 1 : TOPK, qrow, b, nullptr, 0, g);
        }
    } else {
        for (int task = F.bid * NWAVES + w; task < MP * 2; task += F.G * NWAVES) {
            const int qrow = task >> 1, g = task & 1, b = qrow >> 12, t = qrow & (SEQ - 1);
            *(LAS u32x2*)(IL + 4 * lane) = *(const u32x2*)(F.ILG + (size_t)qrow * TOPK + 4 * lane);
            attn_query<false>(F, lane, IL, vst, t + 1 < TOPK ? t + 1 : TOPK, qrow, b, nullptr, 0, g);
        }
    }
    if (w < 4) {
        for (int task = F.bid * 4 + w; task < MS * 2; task += F.G * 4) {
            const int q = task >> 1, g = task & 1, seq = q >> 2, qrow = MP + q;
            *(LAS u32x2*)(IL + 4 * lane) = *(const u32x2*)(F.ILG + (size_t)qrow * TOPK + 4 * lane);
            attn_query<true>(F, lane, IL, vst, TOPK, qrow, 0, F.page_table + seq * PAGES_PER_SEQ, seq, g);
        }
    }
}

__global__ void __launch_bounds__(NTHREADS, 2) fwd_megakernel(Params P) {
    extern __shared__ __attribute__((aligned(16))) unsigned char lds_raw[];
    Frame F;
#define BUILD_FRAME() do { \
    int tid_ = threadIdx.x; asm volatile("" : "+v"(tid_)); \
    unsigned char* ws_ = as_global(P.ws); float* out_ = as_global(P.out); \
    F.lds = (LAS unsigned char*)lds_raw; \
    F.tid = tid_; F.lane = F.tid & 63; F.wave = __builtin_amdgcn_readfirstlane(F.tid >> 6); F.G = gridDim.x; F.bid = blockIdx.x; \
    F.x_p = as_global(P.in[0]); F.x_s = as_global(P.in[1]); F.cache_k = as_global(P.in[2]); F.cache_v = as_global(P.in[3]); F.cache_ki = as_global(P.in[4]); F.state_pool = as_global(P.in[5]); F.page_table = as_global((const int*)P.in[6]); \
    F.c_p = as_global(P.in[7]); F.c_s = as_global(P.in[8]); F.g_mix = as_global(P.in[9]); F.g_ffn = as_global(P.in[10]); F.w_mod = as_global(P.in[11]); F.b_mod = as_global(P.in[12]); F.w_in = as_global(P.in[13]); F.w_o = as_global(P.in[14]); \
    F.pool_w = as_global(P.in[15]); F.pool_scale = as_global(P.in[16]); F.w_up = as_global(P.in[17]); F.w_down = as_global(P.in[18]); F.g_final = as_global(P.in[19]); \
    F.out = out_; F.ws = ws_; \
    F.MOD = (float*)(ws_ + WS_MOD); F.SILU = (bf16_t*)(ws_ + WS_SILU); F.WIN = (bf16_t*)(ws_ + WS_WIN); F.WO = (bf16_t*)(ws_ + WS_WO); F.WPOOL = (bf16_t*)(ws_ + WS_WPOOL); \
    F.WUP = (bf16_t*)(ws_ + WS_WUP); F.WDN = (bf16_t*)(ws_ + WS_WDN); F.HB = (bf16_t*)(ws_ + WS_HB); F.QB = (bf16_t*)(ws_ + WS_QB); F.KB = (bf16_t*)(ws_ + WS_KB); F.VB = (bf16_t*)(ws_ + WS_VB); \
    F.QIB = (bf16_t*)(ws_ + WS_QIB); F.KIB = (bf16_t*)(ws_ + WS_KIB); F.WIF = (float*)(ws_ + WS_WIF); F.OB = (bf16_t*)(ws_ + WS_OB); F.X = (float*)(ws_ + WS_X); F.UB = (bf16_t*)(ws_ + WS_UB); F.ILG = (unsigned short*)(ws_ + WS_IL); \
    mod0 = F.MOD; mod1 = F.MOD + (size_t)NBROW * NMOD; } while (0)
    const float* mod0; const float* mod1;
    unsigned char* ws = P.ws;
    volatile LAS unsigned* MISC = (volatile LAS unsigned*)((LAS unsigned char*)lds_raw + MISC_OFF);
    for (int u = threadIdx.x; u < 64; u += NTHREADS) MISC[u] = 0u;
    __syncthreads();
    XcdBarrier bar = xcd_barrier_post((unsigned*)(ws + WS_CTL) + CW_BAR, MISC + 8);
#define GRID_BAR() do { xcd_barrier(bar); BUILD_FRAME(); } while (0)

    BUILD_FRAME();
    p0(F);
    cg::this_grid().sync();
    BUILD_FRAME();
    rowpass<3>(F, F.x_p, F.x_s, F.g_mix, mod0, 0, 1, F.HB);
    GRID_BAR();
    {   pg8::Gemm g{F.HB, F.WIN, MT, NPROJ, D, D, D, 0}; pg8::MixOrder S; S.init(MP, MS, NPROJ, D, 1, F.G, F.bid);
        EpiProj E{F.QB, F.KB, F.VB, F.QIB, F.KIB, F.WIF, F.out};
        pg8::gemm_phase<EpiProj, pg8::MixOrder, true>(F.lds, g, S, E); }
    GRID_BAR();
    dsa_select_phase(F);
    GRID_BAR();
    dsa_attn_phase(F, (unsigned*)(ws + WS_CTL) + CW_BAR, MISC + 8);
    GRID_BAR();
    {   pg8::Gemm g{F.OB, F.WO, MT, D, D, D, D, 0}; pg8::MixOrder S; S.init(MP, MS, D, D, 4, F.G, F.bid);
        EpiRes E{F.x_p, F.x_s, F.X, mod0 + 2 * D, nullptr};
        pg8::gemm_phase<EpiRes, pg8::MixOrder, true>(F.lds, g, S, E); }
    GRID_BAR();
    rowpass<0>(F, F.X, F.X + (size_t)MP * D, F.g_ffn, mod0, 3, 4, F.HB);
    GRID_BAR();
    {   pg8::Gemm g{F.HB, F.WUP, MT, DFF, D, D, D, 0}; pg8::MixOrder S; S.init(MP, MS, DFF, D, 1, F.G, F.bid);
        EpiUp E{F.UB};
        pg8::gemm_phase<EpiUp, pg8::MixOrder, true>(F.lds, g, S, E); }
    GRID_BAR();
    {   pg8::Gemm g{F.UB, F.WDN, MT, D, DFF, DFF, DFF, 0}; pg8::MixOrder S; S.init(MP, MS, D, DFF, 8, F.G, F.bid);
        EpiRes E{F.X, F.X + (size_t)MP * D, F.X, mod0 + 5 * D, nullptr};
        pg8::gemm_phase<EpiRes, pg8::MixOrder, true>(F.lds, g, S, E); }
    GRID_BAR();
    rowpass<1>(F, F.X, F.X + (size_t)MP * D, F.g_mix + D, mod1, 0, 1, F.HB);
    GRID_BAR();
    poolpass(F, F.HB, F.OB);
    GRID_BAR();
    {   pg8::Gemm g{F.OB, F.WPOOL, MT, D, 256, D, 256, 256}; pg8::MixOrder S; S.init(MP, MS, D, 256, 1, F.G, F.bid);
        EpiRes E{F.X, F.X + (size_t)MP * D, F.X, mod1 + 2 * D, F.pool_scale};
        pg8::gemm_phase<EpiRes, pg8::MixOrder, true>(F.lds, g, S, E); }
    GRID_BAR();
    rowpass<0>(F, F.X, F.X + (size_t)MP * D, F.g_ffn + D, mod1, 3, 4, F.HB);
    GRID_BAR();
    {   pg8::Gemm g{F.HB, F.WUP + (size_t)D * DFF, MT, DFF, D, D, D, 0}; pg8::MixOrder S; S.init(MP, MS, DFF, D, 1, F.G, F.bid);
        EpiUp E{F.UB};
        pg8::gemm_phase<EpiUp, pg8::MixOrder, true>(F.lds, g, S, E); }
    GRID_BAR();
    {   pg8::Gemm g{F.UB, F.WDN + (size_t)D * DFF, MT, D, DFF, DFF, DFF, 0}; pg8::MixOrder S; S.init(MP, MS, D, DFF, 8, F.G, F.bid);
        EpiRes E{F.X, F.X + (size_t)MP * D, F.X, mod1 + 5 * D, nullptr};
        pg8::gemm_phase<EpiRes, pg8::MixOrder, true>(F.lds, g, S, E); }
    GRID_BAR();
    rowpass<2>(F, F.X, F.X + (size_t)MP * D, F.g_final, nullptr, 0, 0, nullptr);
}

extern "C" void kernel_launch(void* const* d_in, const int* in_sizes, int n_in, void* d_out, int out_size, void* d_ws, size_t ws_size, hipStream_t stream) {
    static int grid = 0;
    if (grid == 0) {
        if (n_in != 20 || (size_t)out_size != O_END || ws_size < WS_END) { fprintf(stderr, "kernel_launch: unexpected shapes (n_in %d out %d ws %zu)\n", n_in, out_size, ws_size); grid = -1; return; }
        int dev = 0, cus = 0, per_cu = 0;
        if (hipGetDevice(&dev) != hipSuccess || hipDeviceGetAttribute(&cus, hipDeviceAttributeMultiprocessorCount, dev) != hipSuccess) { grid = -1; return; }
        if (hipFuncSetAttribute((const void*)fwd_megakernel, hipFuncAttributeMaxDynamicSharedMemorySize, LDS_BYTES) != hipSuccess) { fprintf(stderr, "kernel_launch: hipFuncSetAttribute failed\n"); grid = -1; return; }
        if (hipOccupancyMaxActiveBlocksPerMultiprocessor(&per_cu, (const void*)fwd_megakernel, NTHREADS, LDS_BYTES) != hipSuccess || per_cu < 1) { fprintf(stderr, "kernel_launch: occupancy query failed (%d)\n", per_cu); (void)hipGetLastError(); grid = -1; return; }
        grid = cus;
    }
    if (grid < 0) return;
    (void)hipMemsetAsync((char*)d_ws + WS_CTL, 0, CTL_ZERO_BYTES, stream);
    Params p{};
    for (int i = 0; i < 20; ++i) p.in[i] = (const float*)d_in[i];
    p.out = (float*)d_out; p.ws = (unsigned char*)d_ws;
    void* args[] = {&p};
    hipError_t e = hipLaunchCooperativeKernel((const void*)fwd_megakernel, dim3(grid), dim3(NTHREADS), args, LDS_BYTES, stream);
    if (e != hipSuccess) fprintf(stderr, "cooperative launch failed: %s (grid %d)\n", hipGetErrorString(e), grid);
}
```

```cpp
#include <hip/hip_runtime.h>
#include <hip/hip_cooperative_groups.h>
#include <cstdio>
#include <cstdint>
namespace cg = cooperative_groups;

#define LAS __attribute__((address_space(3)))
typedef unsigned short bf16_t;
typedef short bf16x8 __attribute__((ext_vector_type(8)));
typedef short s16x4 __attribute__((ext_vector_type(4)));
typedef float f32x2 __attribute__((ext_vector_type(2)));
typedef float f32x4 __attribute__((ext_vector_type(4)));
typedef float f32x16 __attribute__((ext_vector_type(16)));
typedef unsigned u32x2 __attribute__((ext_vector_type(2)));
typedef unsigned u32x4 __attribute__((ext_vector_type(4)));
typedef __bf16 bf16x2_t __attribute__((ext_vector_type(2)));

constexpr int D = 1024, NBATCH = 4, SEQ = 4096, MP = NBATCH * SEQ, DECB = 128, DECS = 4, MS = DECB * DECS, MT = MP + MS;
constexpr int PAST = 2048, PAGE = 128, PAGES_PER_SEQ = 16;
constexpr int NH = 8, HD = 128, NKV = 2, KVW = NKV * HD, IH = 8, IDD = 64, QIW = IH * IDD, TOPK = 256;
constexpr int DFF = 4096, DPROJ = 2120, NPROJ = 2304, NMOD = 6 * D, NBROW = NBATCH + DECB;
constexpr int POOLST = 15;
constexpr float RMS_EPS = 1e-6f;
constexpr size_t O_YP = 0, O_YS = O_YP + (size_t)MP * D, O_KP = O_YS + (size_t)MS * D, O_VP = O_KP + (size_t)MP * KVW, O_KIP = O_VP + (size_t)MP * KVW,
                 O_POOLP = O_KIP + (size_t)MP * IDD, O_KS = O_POOLP + (size_t)NBATCH * POOLST * D, O_VS = O_KS + (size_t)MS * KVW, O_KIS = O_VS + (size_t)MS * KVW,
                 O_POOLS = O_KIS + (size_t)MS * IDD, O_END = O_POOLS + (size_t)DECB * POOLST * D;
constexpr size_t MiB = 1u << 20;
constexpr size_t WS_CTL = 0, CTL_ZERO_BYTES = 1 * MiB, WS_MOD = 1 * MiB, WS_SILU = 8 * MiB, WS_WIN = 9 * MiB, WS_WO = 14 * MiB, WS_WPOOL = 16 * MiB, WS_WUP = 17 * MiB,
                 WS_WDN = 33 * MiB, WS_HB = 49 * MiB, WS_QB = 82 * MiB, WS_KB = 115 * MiB, WS_VB = 124 * MiB, WS_QIB = 133 * MiB, WS_KIB = 150 * MiB, WS_WIF = 153 * MiB,
                 WS_OB = 154 * MiB, WS_X = 187 * MiB, WS_UB = 253 * MiB, WS_IL = 385 * MiB, WS_GS = 394 * MiB, WS_SHB = 396 * MiB, WS_BIAS = 397 * MiB, WS_SLAB = 405 * MiB, WS_END = 421 * MiB;
constexpr int CW_BAR = 4096, CW_SSQ = 16384;
static_assert((CW_SSQ + 4 * MT) * 4 <= (int)CTL_ZERO_BYTES, "CTL map");
constexpr int RING_BYTES = 131072, IDXL_OFF = RING_BYTES, MISC_OFF = IDXL_OFF + 4096, HIST_OFF = MISC_OFF + 256, LDS_BYTES = 147456;
static_assert(HIST_OFF + 8 * 1024 <= LDS_BYTES, "LDS map");
constexpr int NWAVES = 8, NTHREADS = 512;

#define GAS __attribute__((address_space(1)))
template <class T> __device__ __forceinline__ T* as_global(T* p) { GAS T* g = (GAS T*)p; asm volatile("" : "+s"(g)); return (T*)g; }
__device__ __forceinline__ unsigned pk2(float lo, float hi) { f32x2 v = {lo, hi}; bf16x2_t b = __builtin_convertvector(v, bf16x2_t); return __builtin_bit_cast(unsigned, b); }
__device__ __forceinline__ float bflo(unsigned u) { return __uint_as_float(u << 16); }
__device__ __forceinline__ float bfhi(unsigned u) { return __uint_as_float(u & 0xffff0000u); }
__device__ __forceinline__ bf16x8 pack8(f32x4 a, f32x4 b) { u32x4 w; w.x = pk2(a[0], a[1]); w.y = pk2(a[2], a[3]); w.z = pk2(b[0], b[1]); w.w = pk2(b[2], b[3]); return __builtin_bit_cast(bf16x8, w); }
#define LDS_WAIT() asm volatile("s_waitcnt lgkmcnt(0)" ::: "memory")
#define VM_WAIT() asm volatile("s_waitcnt vmcnt(0)" ::: "memory")

namespace pg8 {
constexpr int BM = 256, BK = 64, HALF = 128, HTB = HALF * BK * 2, STAGE_BYTES = 8 * HTB, NXCD = 8, WGM = 8;
__host__ __device__ __forceinline__ int lds_byte(int r, int c) { const int st = (r >> 4) * 2 + (c >> 5), rr = r & 15, cc = c & 31, ob = rr * 64 + cc * 2; return st * 1024 + (ob ^ (((ob >> 9) & 1) << 5)); }
__host__ __device__ __forceinline__ void stage_rc(int b, int& R, int& C) { const int st = b / 1024, sb = b % 1024, swz = sb ^ (((sb >> 9) & 1) << 5); R = (st >> 1) * 16 + swz / 64; C = (st & 1) * 32 + (swz % 64) / 2; }
__host__ __device__ __forceinline__ int perm32(int rho) { const int n = rho >> 4, i = rho & 15; return 8 * (i >> 2) + 4 * n + (i & 3); }
struct Unit { int pm, pn, k0, nt; bool atomic; };
struct Gemm { const bf16_t* A; const bf16_t* Bt; int M, N, K, lda, ldb, acol; };
struct MixOrder {
    int nMp, nMs, nN, nP, nS, S, ntFull, G, c;
    __device__ void init(int Mp, int Ms, int N, int K, int S_, int G_, int c_) { nMp = Mp / BM; nMs = Ms / BM; nN = N / BM; nP = nMp * nN; S = S_; nS = nMs * nN * S; ntFull = K / BK; G = G_; c = c_; }
    __device__ bool next(int i, Unit& u) const {
        const long L = (long)i * G + c; if (L >= nP + nS) return false;
        if (L < nP) {
            int wgid = (int)L; { const int q = nP / NXCD, r = nP % NXCD, xcd = wgid % NXCD, off = wgid / NXCD; wgid = (xcd < r ? xcd * (q + 1) : r * (q + 1) + (xcd - r) * q) + off; }
            const int nig = WGM * nN, gid = wgid / nig, fm = gid * WGM, gsz = (nMp - fm) < WGM ? (nMp - fm) : WGM;
            u.pm = fm + ((wgid % nig) % gsz); u.pn = (wgid % nig) / gsz; u.k0 = 0; u.nt = ntFull; u.atomic = false;
        } else {
            const int s_ = (int)L - nP, ks = s_ % S, q = s_ / S;
            u.pn = q % nN; u.pm = nMp + q / nN; u.nt = ntFull / S; u.k0 = ks * u.nt; u.atomic = S > 1;
        }
        return true;
    }
    __device__ __forceinline__ void a_ready(const Unit&) const {}
    __device__ __forceinline__ void done(const Unit&) const {}
};

template <class Epi, class Sched, bool ALIGN_EPI>
__device__ __forceinline__ void gemm_phase(LAS unsigned char* lds, const Gemm g, const Sched& S, const Epi& E) {
    int tid_ = threadIdx.x; asm volatile("" : "+v"(tid_));
    const int tid = tid_, wid = __builtin_amdgcn_readfirstlane(tid >> 6), lane = tid & 63, wr = wid >> 2, wc = wid & 3, fr = lane & 15, fq = lane >> 4;
    unsigned voffA[2], voffB[2];
#pragma unroll
    for (int i = 0; i < 2; ++i) { int R, C; stage_rc(tid * 16 + i * 8192, R, C); const int Rb = Epi::PERM ? ((R & ~31) + perm32(R & 31)) : R;
        voffA[i] = (unsigned)(R * g.lda + C) * 2u; voffB[i] = (unsigned)(Rb * g.ldb + C) * 2u; }
    const size_t kstep = (size_t)(BK * 2);
    const size_t hstepA = (size_t)HALF * g.lda * 2, hstepB = (size_t)HALF * g.ldb * 2;
    const size_t tstepA = 2 * hstepA, tstepB = 2 * hstepB;
    const unsigned ldsw = (unsigned)wid * 1024u;
    const int aoff = lds_byte(wr * 64 + fr, fq * 8), boff = lds_byte(wc * 32 + fr, fq * 8);
#define PG8_SA(b, h) (((b) * 2 + (h)) * HTB)
#define PG8_SB(b, h) ((4 + (b) * 2 + (h)) * HTB)
#define PG8_STAGE(bufoff, gbase, voff) do { _Pragma("unroll") for (int _i = 0; _i < 2; ++_i) \
        __builtin_amdgcn_global_load_lds((const unsigned*)((const char*)(gbase) + (voff)[_i]), (LAS unsigned*)(lds + (bufoff) + ldsw + _i * 8192), 16, 0, 0); } while (0)
#define PG8_LDA(dst, b, h) do { _Pragma("unroll") for (int m = 0; m < 4; ++m) _Pragma("unroll") for (int k = 0; k < 2; ++k) dst[m][k] = *(const LAS bf16x8*)(lds + PG8_SA(b, h) + aoff + m * 2048 + k * 1024); } while (0)
#define PG8_LDB(dst, b, h) do { _Pragma("unroll") for (int n = 0; n < 2; ++n) _Pragma("unroll") for (int k = 0; k < 2; ++k) dst[n][k] = *(const LAS bf16x8*)(lds + PG8_SB(b, h) + boff + n * 2048 + k * 1024); } while (0)
#define PG8_MMA(ai, bj, At, Bt) do { __builtin_amdgcn_s_setprio(1); _Pragma("unroll") for (int m = 0; m < 4; ++m) _Pragma("unroll") for (int n = 0; n < 2; ++n) _Pragma("unroll") for (int k = 0; k < 2; ++k) \
        acc[ai][bj][m][n] = __builtin_amdgcn_mfma_f32_16x16x32_bf16(Bt[n][k], At[m][k], acc[ai][bj][m][n], 0, 0, 0); __builtin_amdgcn_s_setprio(0); } while (0)
#define PG8_WAIT_V(n) asm volatile("s_waitcnt vmcnt(" #n ")" ::: "memory")
#define PG8_WAIT_L(n) asm volatile("s_waitcnt lgkmcnt(" #n ")" ::: "memory")
#define PG8_BAR __builtin_amdgcn_s_barrier()
#define PG8_SCHED __builtin_amdgcn_sched_barrier(0)
#define PG8_UA(u) ((const char*)g.A + (size_t)(u).pm * tstepA + (size_t)(u).pn * (size_t)g.acol * 2 + (size_t)(u).k0 * kstep)
#define PG8_UB(u) ((const char*)g.Bt + (size_t)(u).pn * tstepB + (size_t)(u).k0 * kstep)
    Unit cur, nxt; int ui = 0;
    if (!S.next(0, cur)) return;
    f32x4 acc[2][2][4][2];
#pragma unroll
    for (int a = 0; a < 2; ++a)
#pragma unroll
        for (int b = 0; b < 2; ++b)
#pragma unroll
            for (int m = 0; m < 4; ++m)
#pragma unroll
                for (int n = 0; n < 2; ++n) acc[a][b][m][n] = (f32x4){0.f, 0.f, 0.f, 0.f};
    bf16x8 At[4][2], B0[2][2], B1[2][2];
    const char* cA = PG8_UA(cur); const char* cB = PG8_UB(cur);
    S.a_ready(cur);
    PG8_STAGE(PG8_SB(0, 0), cB, voffB); PG8_STAGE(PG8_SB(0, 1), cB + hstepB, voffB); PG8_STAGE(PG8_SA(0, 0), cA, voffA); PG8_STAGE(PG8_SA(0, 1), cA + hstepA, voffA);
    if (wr == 1) PG8_BAR;
    PG8_WAIT_V(2); PG8_BAR;
    PG8_STAGE(PG8_SB(1, 0), cB + kstep, voffB); PG8_STAGE(PG8_SA(1, 0), cA + kstep, voffA); PG8_STAGE(PG8_SB(1, 1), cB + hstepB + kstep, voffB);
    PG8_WAIT_V(6); PG8_BAR;
    for (;;) {
        const bool has_next = S.next(ui + 1, nxt);
        const char* nA = has_next ? PG8_UA(nxt) : cA; const char* nB = has_next ? PG8_UB(nxt) : cB;
        const int nt = cur.nt;
        for (int t = 0; t < nt; t += 2) {
            const bool last = (t == nt - 2);
            const char* a1 = cA + (size_t)(t + 1) * kstep;
            const char* a2 = last ? nA : cA + (size_t)(t + 2) * kstep; const char* b2 = last ? nB : cB + (size_t)(t + 2) * kstep;
            const char* a3 = a2 + kstep; const char* b3 = b2 + kstep;
            if (last && has_next) S.a_ready(nxt);
            PG8_LDB(B0, 0, 0); PG8_LDB(B1, 0, 1); PG8_SCHED; PG8_LDA(At, 0, 0); PG8_STAGE(PG8_SA(1, 1), a1 + hstepA, voffA);
            PG8_WAIT_V(8); PG8_WAIT_L(0); PG8_BAR; PG8_MMA(0, 0, At, B0); PG8_MMA(0, 1, At, B1); PG8_BAR; PG8_SCHED;
            PG8_LDA(At, 0, 1); PG8_STAGE(PG8_SB(0, 0), b2, voffB); PG8_STAGE(PG8_SB(0, 1), b2 + hstepB, voffB); PG8_STAGE(PG8_SA(0, 0), a2, voffA);
            PG8_WAIT_V(8); PG8_WAIT_L(0); PG8_BAR; PG8_MMA(1, 0, At, B0); PG8_MMA(1, 1, At, B1); PG8_BAR; PG8_SCHED;
            PG8_LDB(B0, 1, 0); PG8_LDB(B1, 1, 1); PG8_SCHED; PG8_LDA(At, 1, 0); PG8_STAGE(PG8_SA(0, 1), a2 + hstepA, voffA);
            PG8_WAIT_V(8); PG8_WAIT_L(0); PG8_BAR; PG8_MMA(0, 0, At, B0); PG8_MMA(0, 1, At, B1); PG8_BAR; PG8_SCHED;
            PG8_LDA(At, 1, 1); PG8_STAGE(PG8_SB(1, 0), b3, voffB); PG8_STAGE(PG8_SB(1, 1), b3 + hstepB, voffB); PG8_STAGE(PG8_SA(1, 0), a3, voffA);
            PG8_WAIT_V(8); PG8_WAIT_L(0); PG8_BAR; PG8_MMA(1, 0, At, B0); PG8_MMA(1, 1, At, B1); PG8_BAR; PG8_SCHED;
        }
        if constexpr (ALIGN_EPI) { if (wr == 0) PG8_BAR; }
        {
            const int psrc = ((lane >> 2) + 16 * (lane & 3)) * 4;
#pragma unroll
            for (int a = 0; a < 2; ++a)
#pragma unroll
                for (int b = 0; b < 2; ++b)
#pragma unroll
                    for (int m = 0; m < 4; ++m)
#pragma unroll
                        for (int n = 0; n < 2; ++n)
                        { const f32x4 v_ = acc[a][b][m][n]; f32x4 r_;
                            r_.x = __int_as_float(__builtin_amdgcn_ds_bpermute(psrc, __float_as_int(v_.x))); r_.y = __int_as_float(__builtin_amdgcn_ds_bpermute(psrc, __float_as_int(v_.y)));
                            r_.z = __int_as_float(__builtin_amdgcn_ds_bpermute(psrc, __float_as_int(v_.z))); r_.w = __int_as_float(__builtin_amdgcn_ds_bpermute(psrc, __float_as_int(v_.w)));
                            acc[a][b][m][n] = r_; }
        }
        E(acc, cur, wr, wc, lane >> 2, lane & 3); S.done(cur);
        if (!has_next) break;
#pragma unroll
        for (int a = 0; a < 2; ++a)
#pragma unroll
            for (int b = 0; b < 2; ++b)
#pragma unroll
                for (int m = 0; m < 4; ++m)
#pragma unroll
                    for (int n = 0; n < 2; ++n) acc[a][b][m][n] = (f32x4){0.f, 0.f, 0.f, 0.f};
        cur = nxt; cA = nA; cB = nB; ++ui;
        if constexpr (ALIGN_EPI) { if (wr == 1) PG8_BAR; }
    }
    PG8_WAIT_V(0);
    if constexpr (!ALIGN_EPI) { if (wr == 0) PG8_BAR; }
    PG8_BAR;
#undef PG8_SA
#undef PG8_SB
#undef PG8_STAGE
#undef PG8_LDA
#undef PG8_LDB
#undef PG8_MMA
#undef PG8_WAIT_V
#undef PG8_WAIT_L
#undef PG8_BAR
#undef PG8_SCHED
#undef PG8_UA
#undef PG8_UB
}
}

#define XB_TMO      128
#define XB_XCNT(j)  (256  + 64 * (j))
#define XB_XSUB(j)  (1280 + 64 * (j))
#define XB_XGEN(j)  (2304 + 64 * (j))
#define XB_TOP      3328
#define XB_TOPGEN   3392
#define XCD_BAR_WORDS 3456
#define XB_SPIN_CAP (1u << 18)
__device__ __forceinline__ unsigned xb_ld(unsigned* p)              { return __hip_atomic_load(p, __ATOMIC_RELAXED, __HIP_MEMORY_SCOPE_AGENT); }
__device__ __forceinline__ unsigned xb_add(unsigned* p, unsigned v) { return __hip_atomic_fetch_add(p, v, __ATOMIC_RELAXED, __HIP_MEMORY_SCOPE_AGENT); }
__device__ __forceinline__ unsigned xb_xcc_id() { return (unsigned)__builtin_amdgcn_s_getreg((3 << 11) | 20) & 0xFu; }
#define XB_SPIN(cond, bar) do { unsigned _sp = 0; while (cond) { __builtin_amdgcn_s_sleep(1); \
    if ((++_sp & 255u) == 0u) { if (xb_ld(&(bar)[XB_TMO])) break; if (_sp > XB_SPIN_CAP) { atomicAdd(&(bar)[XB_TMO], 1u); break; } } } } while (0)
struct XcdBarrier { unsigned* bar; unsigned x; volatile LAS unsigned* st; };
__device__ __forceinline__ XcdBarrier xcd_barrier_post(unsigned* bar, volatile LAS unsigned* st) {
    XcdBarrier b; b.bar = bar; b.x = xb_xcc_id(); b.st = st;
    if (threadIdx.x == 0) { st[2] = xb_add(&bar[XB_XCNT(b.x)], 1u); st[3] = b.x; }
    return b;
}
__device__ __forceinline__ void xcd_barrier_complete(unsigned* bar, unsigned x, unsigned& nloc, unsigned& nx) {
    const unsigned G = gridDim.x * gridDim.y * gridDim.z;
    unsigned sum, cnt, mine, sp = 0u;
    for (;;) {
        sum = 0u; cnt = 0u; mine = 0u;
#pragma unroll
        for (unsigned j = 0; j < 16; ++j) { const unsigned c = xb_ld(&bar[XB_XCNT(j)]); sum += c; cnt += (c > 0u) ? 1u : 0u; mine = (j == x) ? c : mine; }
        if (sum == G) break;
        __builtin_amdgcn_s_sleep(1);
        if ((++sp & 255u) == 0u) { if (xb_ld(&bar[XB_TMO])) break; if (sp > XB_SPIN_CAP) { atomicAdd(&bar[XB_TMO], 1u); break; } }
    }
    nloc = mine > 0u ? mine : 1u; nx = cnt > 0u ? cnt : 1u;
}
__device__ __forceinline__ void xcd_barrier(const XcdBarrier& b) {
    asm volatile("s_waitcnt vmcnt(0)" ::: "memory");
    __syncthreads();
    if (threadIdx.x == 0) {
        unsigned* bar = b.bar;
        __builtin_amdgcn_s_waitcnt(0);
        unsigned nloc = b.st[0], nx = b.st[1];
        if (nloc == 0u) { xcd_barrier_complete(bar, b.x, nloc, nx); b.st[0] = nloc; b.st[1] = nx; }
        const unsigned old = xb_add(&bar[XB_XSUB(b.x)], 1u);
        const unsigned gen = old / nloc;
        if (old + 1u == (gen + 1u) * nloc) {
            __builtin_amdgcn_fence(__ATOMIC_RELEASE, "agent");
            asm volatile("s_waitcnt vmcnt(0)" ::: "memory");
            const unsigned og = xb_add(&bar[XB_TOP], 1u);
            const unsigned tg = og / nx;
            if (og + 1u == (tg + 1u) * nx) xb_add(&bar[XB_TOPGEN], 1u);
            else XB_SPIN(xb_ld(&bar[XB_TOPGEN]) == tg, bar);
            __builtin_amdgcn_fence(__ATOMIC_ACQUIRE, "agent");
            xb_add(&bar[XB_XGEN(b.x)], 1u);
            asm volatile("s_waitcnt vmcnt(0)" ::: "memory");
        } else {
            XB_SPIN(xb_ld(&bar[XB_XGEN(b.x)]) == gen, bar);
            __builtin_amdgcn_fence(__ATOMIC_ACQUIRE, "agent");
            asm volatile("s_waitcnt vmcnt(0)" ::: "memory");
        }
    }
    __syncthreads();
}

struct Params { const float* in[20]; float* out; unsigned char* ws; };
struct Frame {
    LAS unsigned char* lds;
    int tid, lane, wave, G, bid;
    const float *x_p, *x_s, *cache_k, *cache_v, *cache_ki, *state_pool, *c_p, *c_s, *g_mix, *g_ffn, *w_mod, *b_mod, *w_in, *w_o, *pool_w, *pool_scale, *w_up, *w_down, *g_final;
    const int* page_table;
    float* out; unsigned char* ws;
    float* MOD; bf16_t *SILU, *WIN, *WO, *WPOOL, *WUP, *WDN, *HB, *QB, *KB, *VB, *QIB, *KIB, *OB, *UB; float *WIF, *X; unsigned short* ILG; float *GS, *BIAS, *SSQ, *SLAB; bf16_t* SHB;
};
__device__ __forceinline__ int brow_of(int r) { return r < MP ? (r >> 12) : NBATCH + ((r - MP) >> 2); }

struct EpiProj {
    static constexpr bool PERM = true;
    bf16_t *QB, *KB, *VB, *QIB, *KIB; float* WIF; float* out;
    __device__ __forceinline__ void operator()(const f32x4 (&acc)[2][2][4][2], const pg8::Unit& u, int wr, int wc, int fr, int fq) const {
        const int pn = u.pn;
#pragma unroll
        for (int ai = 0; ai < 2; ++ai)
#pragma unroll
            for (int m = 0; m < 4; ++m) {
                const int row = u.pm * 256 + ai * 128 + wr * 64 + m * 16 + fr;
#pragma unroll
                for (int bj = 0; bj < 2; ++bj) {
                    const int cl = bj * 128 + wc * 32 + 8 * fq;
                    const f32x4 v0 = acc[ai][bj][m][0], v1 = acc[ai][bj][m][1];
                    const bf16x8 pk = pack8(v0, v1);
                    if (pn < 4) { *(bf16x8*)(QB + (size_t)row * D + pn * 256 + cl) = pk; }
                    else if (pn == 4 || pn == 5) {
                        bf16_t* B = pn == 4 ? KB : VB; *(bf16x8*)(B + (size_t)row * KVW + cl) = pk;
                        float* o = out + (row < MP ? (pn == 4 ? O_KP : O_VP) + (size_t)row * KVW : (pn == 4 ? O_KS : O_VS) + (size_t)(row - MP) * KVW) + cl;
                        *(f32x4*)o = v0; *(f32x4*)(o + 4) = v1;
                    } else if (pn < 8) { *(bf16x8*)(QIB + (size_t)row * QIW + (pn - 6) * 256 + cl) = pk; }
                    else {
                        if (cl < 64) { *(bf16x8*)(KIB + (size_t)(row >> 5) * (32 * IDD) + ((cl >> 3) * 32 + (row & 31)) * 8) = pk;
                            float* o = out + (row < MP ? O_KIP + (size_t)row * IDD : O_KIS + (size_t)(row - MP) * IDD) + cl; *(f32x4*)o = v0; *(f32x4*)(o + 4) = v1; }
                        else if (cl == 64) { float* o = WIF + (size_t)row * 8; *(f32x4*)o = v0; *(f32x4*)(o + 4) = v1; }
                    }
                }
            }
    }
};
struct EpiUp {
    static constexpr bool PERM = true;
    bf16_t* UB; const float* ssq; const float* bias;
    __device__ __forceinline__ void operator()(const f32x4 (&acc)[2][2][4][2], const pg8::Unit& u, int wr, int wc, int fr, int fq) const {
        float rstd[2][4]; f32x4 bv[2][2];
        const int row0 = u.pm * 256 + wr * 64 + fr, col0 = u.pn * 256 + wc * 32 + 8 * fq;
        const bool uni = u.pm < MP / 256;
#pragma unroll
        for (int ai = 0; ai < 2; ++ai)
#pragma unroll
            for (int m = 0; m < 4; ++m) rstd[ai][m] = ssq[row0 + ai * 128 + m * 16];
        if (uni) { const float* br = bias + (size_t)(row0 >> 12) * DFF + col0;
#pragma unroll
            for (int bj = 0; bj < 2; ++bj) { bv[bj][0] = *(const f32x4*)(br + bj * 128); bv[bj][1] = *(const f32x4*)(br + bj * 128 + 4); } }
#pragma unroll
        for (int ai = 0; ai < 2; ++ai)
#pragma unroll
            for (int m = 0; m < 4; ++m) {
                const int row = row0 + ai * 128 + m * 16;
                const float rs = __builtin_amdgcn_rsqf(rstd[ai][m] * (1.f / D) + RMS_EPS);
                if (!uni) { const float* br = bias + (size_t)brow_of(row) * DFF + col0;
#pragma unroll
                    for (int bj = 0; bj < 2; ++bj) { bv[bj][0] = *(const f32x4*)(br + bj * 128); bv[bj][1] = *(const f32x4*)(br + bj * 128 + 4); } }
#pragma unroll
                for (int bj = 0; bj < 2; ++bj) {
                    f32x4 v0 = acc[ai][bj][m][0] * rs + bv[bj][0], v1 = acc[ai][bj][m][1] * rs + bv[bj][1];
#pragma unroll
                    for (int j = 0; j < 4; ++j) { const float a = __builtin_amdgcn_fmed3f(v0[j], 0.f, __builtin_inff()), b = __builtin_amdgcn_fmed3f(v1[j], 0.f, __builtin_inff()); v0[j] = a * a; v1[j] = b * b; }
                    *(bf16x8*)(UB + (size_t)row * DFF + col0 + bj * 128) = pack8(v0, v1);
                }
            }
    }
};
struct EpiBias {
    static constexpr bool PERM = false;
    float* B;
    __device__ __forceinline__ void operator()(const f32x4 (&acc)[2][2][4][2], const pg8::Unit& u, int wr, int wc, int fr, int fq) const {
#pragma unroll
        for (int ai = 0; ai < 2; ++ai)
#pragma unroll
            for (int m = 0; m < 4; ++m) {
                const int row = u.pm * 256 + ai * 128 + wr * 64 + m * 16 + fr;
#pragma unroll
                for (int bj = 0; bj < 2; ++bj)
#pragma unroll
                    for (int n = 0; n < 2; ++n) { const int c = (u.pn & 15) * 256 + bj * 128 + wc * 32 + 16 * n + 4 * fq; *(f32x4*)(B + (size_t)row * DFF + c) = acc[ai][bj][m][n]; }
            }
    }
};
template <int FUSE> struct EpiRes {
    static constexpr bool PERM = false;
    const float *xin_p, *xin_s;
    float* X; const float* gate;
    const float* cscale;
    const float* gs; bf16_t* XG; float* ssq; bool xin_frag; float* slab;
    __device__ __forceinline__ void operator()(const f32x4 (&acc)[2][2][4][2], const pg8::Unit& u, int wr, int wc, int fr, int fq) const {
        const int row0 = u.pm * 256 + wr * 64 + fr, col0 = u.pn * 256 + wc * 32 + 4 * fq;
        if (u.atomic) {
            float* sl = slab + (size_t)(u.k0 / u.nt) * MS * D;
#pragma unroll
            for (int ai = 0; ai < 2; ++ai)
#pragma unroll
                for (int m = 0; m < 4; ++m) { const int row = row0 + ai * 128 + m * 16; const float* gr = gate + (size_t)brow_of(row) * NMOD;
#pragma unroll
                    for (int bj = 0; bj < 2; ++bj)
#pragma unroll
                        for (int n = 0; n < 2; ++n) { const int c = col0 + bj * 128 + 16 * n; f32x4 a = acc[ai][bj][m][n] * *(const f32x4*)(gr + c); if (cscale) a = a * *(const f32x4*)(cscale + c);
                            *(f32x4*)(sl + (size_t)(row - MP) * D + c) = a; } }
            return;
        }
        const bool uni = u.pm < MP / 256;
        const size_t fbase = ((size_t)((u.pm * 4 + u.pn) * 8 + wr * 4 + wc) * 32) * 256 + (size_t)(4 * fr + fq) * 4;
        f32x4 gv[2][2], sv[2][2];
#pragma unroll
        for (int bj = 0; bj < 2; ++bj)
#pragma unroll
            for (int n = 0; n < 2; ++n) { const int c = col0 + bj * 128 + 16 * n; const int br = uni ? (row0 >> 12) : brow_of(row0);
                gv[bj][n] = *(const f32x4*)(gate + (size_t)br * NMOD + c); if (cscale) gv[bj][n] = gv[bj][n] * *(const f32x4*)(cscale + c);
                if (FUSE == 1) sv[bj][n] = *(const f32x4*)(gs + (size_t)br * D + c); }
#pragma unroll
        for (int g2 = 0; g2 < 4; ++g2) {
            const int ai = g2 >> 1;
            f32x4 xr[2][2][2];
#pragma unroll
            for (int mm = 0; mm < 2; ++mm) { const int m_ = (g2 & 1) * 2 + mm; const int row = row0 + ai * 128 + m_ * 16; const float* xi = row < MP ? xin_p + (size_t)row * D : xin_s + (size_t)(row - MP) * D;
#pragma unroll
                for (int bj = 0; bj < 2; ++bj)
#pragma unroll
                    for (int n = 0; n < 2; ++n) xr[mm][bj][n] = *(const f32x4*)((uni && xin_frag) ? xin_p + fbase + (size_t)((((ai * 4 + m_) * 2 + bj) * 2 + n) * 256) : xi + col0 + bj * 128 + 16 * n); }
#pragma unroll
            for (int mm = 0; mm < 2; ++mm) {
                const int m = (g2 & 1) * 2 + mm;
                const int row = row0 + ai * 128 + m * 16;
                if (!uni && !(g2 == 0 && mm == 0)) { const int brow = brow_of(row);
#pragma unroll
                    for (int bj = 0; bj < 2; ++bj)
#pragma unroll
                        for (int n = 0; n < 2; ++n) { const int c = col0 + bj * 128 + 16 * n; gv[bj][n] = *(const f32x4*)(gate + (size_t)brow * NMOD + c); if (cscale) gv[bj][n] = gv[bj][n] * *(const f32x4*)(cscale + c);
                            if (FUSE == 1) sv[bj][n] = *(const f32x4*)(gs + (size_t)brow * D + c); } }
                float sq = 0.f;
#pragma unroll
                for (int bj = 0; bj < 2; ++bj)
#pragma unroll
                    for (int n = 0; n < 2; ++n) {
                        const f32x4 o = xr[mm][bj][n] + acc[ai][bj][m][n] * gv[bj][n];
                        *(f32x4*)(uni ? X + fbase + (size_t)((((ai * 4 + m) * 2 + bj) * 2 + n) * 256) : X + (size_t)row * D + col0 + bj * 128 + 16 * n) = o;
                        if (FUSE != 0) sq += (o[0] * o[0] + o[1] * o[1]) + (o[2] * o[2] + o[3] * o[3]);
                        if (FUSE == 1) { const f32x4 g = o * sv[bj][n]; u32x2 w2; w2.x = pk2(g[0], g[1]); w2.y = pk2(g[2], g[3]); *(u32x2*)(XG + (size_t)row * D + col0 + bj * 128 + 16 * n) = w2; }
                    }
                if (FUSE != 0) { sq += __shfl_xor(sq, 1); sq += __shfl_xor(sq, 2); if (fq == 0) (void)__hip_atomic_fetch_add(ssq + row, sq, __ATOMIC_RELAXED, __HIP_MEMORY_SCOPE_AGENT); }
            }
        }
    }
};
struct BiasOrder {
    int c;
    __device__ bool next(int i, pg8::Unit& u) const { if (i != 0 || c < 96 || c >= 128) return false; u.pm = (c - 96) >> 4; u.pn = c - 96; u.k0 = 0; u.nt = D / 64; u.atomic = false; return true; }
    __device__ __forceinline__ void a_ready(const pg8::Unit&) const {}
    __device__ __forceinline__ void done(const pg8::Unit&) const {}
};

__device__ __forceinline__ float wave_sum(float v) {
#pragma unroll
    for (int o = 1; o < 64; o <<= 1) v += __shfl_xor(v, o);
    return v;
}
template <int CTRL> __device__ __forceinline__ unsigned dpp_u(unsigned v) { return (unsigned)__builtin_amdgcn_update_dpp(0, (int)v, CTRL, 0xf, 0xf, true); }
__device__ __forceinline__ unsigned wave_sum_u(unsigned v) {
    v += dpp_u<0xB1>(v); v += dpp_u<0x4E>(v); v += dpp_u<0x141>(v); v += dpp_u<0x140>(v);
    return (unsigned)__builtin_amdgcn_readlane((int)v, 0) + (unsigned)__builtin_amdgcn_readlane((int)v, 16) + (unsigned)__builtin_amdgcn_readlane((int)v, 32) + (unsigned)__builtin_amdgcn_readlane((int)v, 48);
}
__device__ __forceinline__ unsigned wave_max_u(unsigned v) {
    unsigned t;
    t = dpp_u<0xB1>(v); v = v > t ? v : t; t = dpp_u<0x4E>(v); v = v > t ? v : t; t = dpp_u<0x141>(v); v = v > t ? v : t; t = dpp_u<0x140>(v); v = v > t ? v : t;
    const unsigned a = (unsigned)__builtin_amdgcn_readlane((int)v, 0), b = (unsigned)__builtin_amdgcn_readlane((int)v, 16), c = (unsigned)__builtin_amdgcn_readlane((int)v, 32), d = (unsigned)__builtin_amdgcn_readlane((int)v, 48);
    const unsigned ab = a > b ? a : b, cd = c > d ? c : d; return ab > cd ? ab : cd;
}

__device__ __forceinline__ void transpose_item(const float* W, int N, bf16_t* WT, int ldo, int row_off, LAS float* scr, int kb, int nb, int lane) {
    const int k0 = 64 * kb, n0 = 32 * nb;
    const int n = n0 + 4 * (lane & 7);
    f32x4 v[8];
#pragma unroll
    for (int i = 0; i < 8; ++i) { const int kk = 8 * i + (lane >> 3); v[i] = (n < N) ? *(const f32x4*)(W + (size_t)(k0 + kk) * N + n) : (f32x4){0.f, 0.f, 0.f, 0.f}; }
#pragma unroll
    for (int i = 0; i < 8; ++i) { const int kk = 8 * i + (lane >> 3); LAS float* d = scr + kk * 33 + 4 * (lane & 7); d[0] = v[i][0]; d[1] = v[i][1]; d[2] = v[i][2]; d[3] = v[i][3]; }
    LDS_WAIT(); asm volatile("" ::: "memory");
    const int c = lane & 7;
#pragma unroll
    for (int j = 0; j < 4; ++j) { const int nn = (lane >> 3) + 8 * j; const LAS float* s = scr + (8 * c) * 33 + nn;
        u32x4 o; o.x = pk2(s[0 * 33], s[1 * 33]); o.y = pk2(s[2 * 33], s[3 * 33]); o.z = pk2(s[4 * 33], s[5 * 33]); o.w = pk2(s[6 * 33], s[7 * 33]);
        *(u32x4*)(WT + (size_t)(row_off + n0 + nn) * ldo + k0 + 8 * c) = o; }
    LDS_WAIT(); asm volatile("" ::: "memory");
}

constexpr int CW_SILU = 8192;
__device__ __forceinline__ void p0_mod_task(Frame& F, int task, unsigned* flag) {
    const int col = F.lane & 15, kq = F.lane >> 4;
    const int l = task / (NMOD / 16), n0 = (task % (NMOD / 16)) * 16;
    const float* W = F.w_mod + (size_t)l * D * NMOD + n0 + col;
    f32x4 acc[9];
#pragma unroll
    for (int i = 0; i < 9; ++i) acc[i] = (f32x4){0.f, 0.f, 0.f, 0.f};
    { unsigned sp = 0; while (__hip_atomic_load(flag, __ATOMIC_RELAXED, __HIP_MEMORY_SCOPE_AGENT) < 144u) { __builtin_amdgcn_s_sleep(4); if (++sp > (1u << 22)) break; }
      __builtin_amdgcn_fence(__ATOMIC_ACQUIRE, "agent"); asm volatile("s_waitcnt vmcnt(0)" ::: "memory"); }
#pragma unroll 8
    for (int ks = 0; ks < D / 32; ++ks) {
        const int k0 = 32 * ks + 8 * kq;
        float f[8];
#pragma unroll
        for (int j = 0; j < 8; ++j) f[j] = W[(size_t)(k0 + j) * NMOD];
        u32x4 bw; bw.x = pk2(f[0], f[1]); bw.y = pk2(f[2], f[3]); bw.z = pk2(f[4], f[5]); bw.w = pk2(f[6], f[7]);
        const bf16x8 bfr = __builtin_bit_cast(bf16x8, bw);
#pragma unroll
        for (int mt = 0; mt < 9; ++mt) {
            const bf16x8 a = *(const bf16x8*)(F.SILU + (size_t)(16 * mt + col) * D + k0);
            acc[mt] = __builtin_amdgcn_mfma_f32_16x16x32_bf16(a, bfr, acc[mt], 0, 0, 0);
        }
    }
    const float bias = F.b_mod[(size_t)l * NMOD + n0 + col];
#pragma unroll
    for (int mt = 0; mt < 9; ++mt)
#pragma unroll
        for (int r = 0; r < 4; ++r) { const int row = 16 * mt + 4 * kq + r; if (row < NBROW) F.MOD[((size_t)l * NBROW + row) * NMOD + n0 + col] = acc[mt][r] + bias; }
}
__device__ __forceinline__ void p0(Frame& F) {
    LAS float* scr = (LAS float*)(F.lds + F.wave * 16384);
    unsigned* flag = (unsigned*)(F.ws + WS_CTL) + CW_SILU;
    const int gw = F.bid * NWAVES + F.wave, NGW = F.G * NWAVES;
    constexpr int I_IN = (D / 64) * (NPROJ / 32), I_O = (D / 64) * (D / 32), I_P = 4 * (256 / 64) * (256 / 32), I_UP = (D / 64) * (DFF / 32), I_DN = (DFF / 64) * (D / 32);
    constexpr int N_SILU = 144, N_MOD = 2 * (NMOD / 16);
    constexpr int NIT = N_SILU + N_MOD + I_IN + I_O + I_P + 2 * I_UP + 2 * I_DN;
    for (int it = gw; it < NIT; it += NGW) {
        int r = it;
        if (r < N_SILU) {
            const float* c = r < NBATCH ? F.c_p + (size_t)r * D : F.c_s + (size_t)(r - NBATCH) * D;
#pragma unroll
            for (int j = 0; j < 4; ++j) {
                f32x4 v = {0.f, 0.f, 0.f, 0.f};
                if (r < NBROW) { v = *(const f32x4*)(c + 4 * F.lane + 256 * j);
#pragma unroll
                    for (int e = 0; e < 4; ++e) v[e] = v[e] * __builtin_amdgcn_rcpf(1.f + __expf(-v[e])); }
                u32x2 o; o.x = pk2(v[0], v[1]); o.y = pk2(v[2], v[3]);
                *(u32x2*)(F.SILU + (size_t)r * D + 4 * F.lane + 256 * j) = o;
            }
            asm volatile("s_waitcnt vmcnt(0)" ::: "memory");
            if (F.lane == 0) { __builtin_amdgcn_fence(__ATOMIC_RELEASE, "agent"); asm volatile("s_waitcnt vmcnt(0)" ::: "memory"); (void)__hip_atomic_fetch_add(flag, 1u, __ATOMIC_RELAXED, __HIP_MEMORY_SCOPE_AGENT); }
            continue;
        } r -= N_SILU;
        if (r < N_MOD) { p0_mod_task(F, r, flag); continue; } r -= N_MOD;
        if (r < I_IN) { transpose_item(F.w_in, DPROJ, F.WIN, D, 0, scr, r / (NPROJ / 32), r % (NPROJ / 32), F.lane); continue; } r -= I_IN;
        if (r < I_O) { transpose_item(F.w_o, D, F.WO, D, 0, scr, r / (D / 32), r % (D / 32), F.lane); continue; } r -= I_O;
        if (r < I_P) { const int g = r / 32, q = r % 32; transpose_item(F.pool_w + (size_t)g * 65536, 256, F.WPOOL, 256, g * 256, scr, q / 8, q % 8, F.lane); continue; } r -= I_P;
        if (r < 2 * I_UP) { const int l = r / I_UP, q = r % I_UP; transpose_item(F.w_up + (size_t)l * D * DFF, DFF, F.WUP + (size_t)l * D * DFF, D, 0, scr, q / (DFF / 32), q % (DFF / 32), F.lane); continue; } r -= 2 * I_UP;
        { const int l = r / I_DN, q = r % I_DN; transpose_item(F.w_down + (size_t)l * D * DFF, D, F.WDN + (size_t)l * D * DFF, DFF, 0, scr, q / (D / 32), q % (D / 32), F.lane); }
    }
}

template <int MODE>
__device__ __forceinline__ void rowpass(Frame& F, const float* src_p, const float* src_s, const float* gain, const float* mod_l, int sh_chunk, int sc_chunk, bf16_t* dst) {
    const int gw = F.bid * NWAVES + F.wave, NGW = F.G * NWAVES;
    for (int r = gw; r < MT; r += NGW) {
        const float* xr = r < MP ? src_p + (size_t)r * D : src_s + (size_t)(r - MP) * D;
        f32x4 v[4]; float s = 0.f;
#pragma unroll
        for (int j = 0; j < 4; ++j) { v[j] = *(const f32x4*)(xr + 4 * F.lane + 256 * j); s += (v[j].x * v[j].x + v[j].y * v[j].y) + (v[j].z * v[j].z + v[j].w * v[j].w); }
        const float rstd = (MODE == 2 && r < MP) ? __builtin_amdgcn_rsqf(F.SSQ[3 * MT + r] * (1.f / D) + RMS_EPS) : __builtin_amdgcn_rsqf(wave_sum(s) * (1.f / D) + RMS_EPS);
        if (MODE == 2) {
            float* o = r < MP ? F.out + O_YP + (size_t)r * D : F.out + O_YS + (size_t)(r - MP) * D;
#pragma unroll
            for (int j = 0; j < 4; ++j) { const int c = 4 * F.lane + 256 * j; *(f32x4*)(o + c) = v[j] * rstd * *(const f32x4*)(gain + c); }
        } else {
            const float* mr = mod_l + (size_t)brow_of(r) * NMOD;
            float* po = nullptr;
            if (MODE == 1) {
                if (r < MP) { const int t = r & (SEQ - 1); if (t >= SEQ - POOLST) po = F.out + O_POOLP + ((size_t)(r >> 12) * POOLST + (t - (SEQ - POOLST))) * D; }
                else { const int q = r - MP; po = F.out + O_POOLS + ((size_t)(q >> 2) * POOLST + (POOLST - DECS) + (q & 3)) * D; }
            }
#pragma unroll
            for (int j = 0; j < 4; ++j) { const int c = 4 * F.lane + 256 * j;
                const f32x4 h = v[j] * rstd * *(const f32x4*)(gain + c) * (*(const f32x4*)(mr + sc_chunk * D + c) + 1.0f) + *(const f32x4*)(mr + sh_chunk * D + c);
                u32x2 o; o.x = pk2(h[0], h[1]); o.y = pk2(h[2], h[3]);
                *(u32x2*)(dst + (size_t)r * D + c) = o;
                if (MODE == 3 && r >= MP) *(f32x4*)(F.X + (size_t)r * D + c) = v[j];
                if (MODE == 1 && po) *(f32x4*)(po + c) = h; }
        }
    }
    if (MODE == 3) {
        for (int it = gw; it < 3 * NBROW + 2 * 256; it += NGW) {
            if (it < 3 * NBROW) { const int inst = it / NBROW, br = it % NBROW;
                const float* g = inst == 0 ? F.g_ffn : inst == 1 ? F.g_mix + D : F.g_ffn + D;
                const float* sc = F.MOD + ((size_t)(inst == 0 ? 0 : 1) * NBROW + br) * NMOD + (inst == 1 ? 1 : 4) * D;
#pragma unroll
                for (int j = 0; j < 4; ++j) { const int c = 4 * F.lane + 256 * j; *(f32x4*)(F.GS + ((size_t)inst * NBROW + br) * D + c) = *(const f32x4*)(g + c) * (*(const f32x4*)(sc + c) + 1.0f); }
            } else { const int q = it - 3 * NBROW, l = q >> 8, br = q & 255;
#pragma unroll
                for (int j = 0; j < 4; ++j) { const int c = 4 * F.lane + 256 * j; f32x4 v = {0.f, 0.f, 0.f, 0.f}; if (br < NBROW) v = *(const f32x4*)(F.MOD + ((size_t)l * NBROW + br) * NMOD + 3 * D + c);
                    u32x2 o; o.x = pk2(v[0], v[1]); o.y = pk2(v[2], v[3]); *(u32x2*)(F.SHB + ((size_t)l * 256 + br) * D + c) = o; }
            }
        }
    }
    if (MODE == 1) {
        for (int it = gw; it < DECB * (POOLST - DECS); it += NGW) { const int seq = it / (POOLST - DECS), i = it % (POOLST - DECS);
            const float* s = F.state_pool + ((size_t)seq * POOLST + i + DECS) * D; float* o = F.out + O_POOLS + ((size_t)seq * POOLST + i) * D;
#pragma unroll
            for (int j = 0; j < 4; ++j) *(f32x4*)(o + 4 * F.lane + 256 * j) = *(const f32x4*)(s + 4 * F.lane + 256 * j); }
    }
}

__device__ __forceinline__ void finalpass(Frame& F) {
    const int gw = F.bid * NWAVES + F.wave, NGW = F.G * NWAVES;
    const float* ssq = F.SSQ + 3 * MT;
    const int fr = F.lane >> 2, fq = F.lane & 3;
#pragma unroll 2
    for (int it = gw; it < (MP / 256) * 4 * 8 * 8; it += NGW) {
        const int am = it & 7, wid = (it >> 3) & 7, tile = it >> 6, pm = tile >> 2, pn = tile & 3, wr = wid >> 2, wc = wid & 3;
        const int row = pm * 256 + (am >> 2) * 128 + wr * 64 + (am & 3) * 16 + fr;
        const float rs = __builtin_amdgcn_rsqf(ssq[row] * (1.f / D) + RMS_EPS);
        const float* xb = F.X + ((size_t)(tile * 8 + wid) * 32 + am * 4) * 256 + F.lane * 4;
        f32x4 v[4];
#pragma unroll
        for (int q = 0; q < 4; ++q) v[q] = *(const f32x4*)(xb + q * 256);
#pragma unroll
        for (int q = 0; q < 4; ++q) { const int c = pn * 256 + (q >> 1) * 128 + wc * 32 + 16 * (q & 1) + 4 * fq;
            *(f32x4*)(F.out + O_YP + (size_t)row * D + c) = v[q] * rs * *(const f32x4*)(F.g_final + c); }
    }
    for (int r = gw; r < MS; r += NGW) {
        const float* xr = F.X + (size_t)(MP + r) * D;
        f32x4 v[4]; float s = 0.f;
#pragma unroll
        for (int j = 0; j < 4; ++j) { const int c = 4 * F.lane + 256 * j; v[j] = *(const f32x4*)(xr + c);
#pragma unroll
            for (int ks = 0; ks < 8; ++ks) v[j] += *(const f32x4*)(F.SLAB + ((size_t)ks * MS + r) * D + c);
            s += (v[j].x * v[j].x + v[j].y * v[j].y) + (v[j].z * v[j].z + v[j].w * v[j].w); }
        const float rstd = __builtin_amdgcn_rsqf(wave_sum(s) * (1.f / D) + RMS_EPS);
#pragma unroll
        for (int j = 0; j < 4; ++j) { const int c = 4 * F.lane + 256 * j; *(f32x4*)(F.out + O_YS + (size_t)r * D + c) = v[j] * rstd * *(const f32x4*)(F.g_final + c); }
    }
}

__device__ __forceinline__ void poolpass(Frame& F, const bf16_t* XG, const float* ssq, const float* mod_l, bf16_t* PB) {
    const bool ded = F.G >= 2 * DECB;
    const bool smp_wave = ded && F.bid < DECB && F.wave == NWAVES - 1;
    const int pw = !ded ? F.bid * NWAVES + F.wave : (F.bid < DECB ? F.bid * (NWAVES - 1) + F.wave : DECB * (NWAVES - 1) + (F.bid - DECB) * NWAVES + F.wave);
    const int gt = pw * 64 + F.lane, NGT = (ded ? F.G * NWAVES - DECB : F.G * NWAVES) * 64;
    if (!smp_wave)
    for (int it = gt; it < (MP / 16) * 128; it += NGT) {
        const int run = it >> 7, c8 = it & 127, g = c8 >> 5, w = 2 << g;
        const int r0 = run * 16, t0 = r0 & (SEQ - 1);
        const bf16_t* xg = XG + 8 * c8;
        float s[8];
#pragma unroll
        for (int e = 0; e < 8; ++e) s[e] = 0.f;
        for (int j = 1; j < w; ++j) { if (t0 - j >= 0) { const u32x4 a = *(const u32x4*)(xg + (size_t)(r0 - j) * D); const float rs = __builtin_amdgcn_rsqf(ssq[r0 - j] * (1.f / D) + RMS_EPS);
            s[0] += bflo(a.x) * rs; s[1] += bfhi(a.x) * rs; s[2] += bflo(a.y) * rs; s[3] += bfhi(a.y) * rs; s[4] += bflo(a.z) * rs; s[5] += bfhi(a.z) * rs; s[6] += bflo(a.w) * rs; s[7] += bfhi(a.w) * rs; } }
        const float* sh = mod_l + (size_t)(r0 >> 12) * NMOD + 8 * c8;
#pragma unroll 4
        for (int i = 0; i < 16; ++i) {
            const int r = r0 + i, t = t0 + i;
            const u32x4 a = *(const u32x4*)(xg + (size_t)r * D); const float rs = __builtin_amdgcn_rsqf(ssq[r] * (1.f / D) + RMS_EPS);
            const float a0[8] = {bflo(a.x) * rs, bfhi(a.x) * rs, bflo(a.y) * rs, bfhi(a.y) * rs, bflo(a.z) * rs, bfhi(a.z) * rs, bflo(a.w) * rs, bfhi(a.w) * rs};
#pragma unroll
            for (int e = 0; e < 8; ++e) s[e] += a0[e];
            const int n = (t + 1) < w ? (t + 1) : w;
            const float ic = __builtin_amdgcn_rcpf((float)n);
            u32x4 o; o.x = pk2(s[0] * ic - a0[0], s[1] * ic - a0[1]); o.y = pk2(s[2] * ic - a0[2], s[3] * ic - a0[3]); o.z = pk2(s[4] * ic - a0[4], s[5] * ic - a0[5]); o.w = pk2(s[6] * ic - a0[6], s[7] * ic - a0[7]);
            *(u32x4*)(PB + (size_t)r * D + 8 * c8) = o;
            if (t >= SEQ - POOLST) {
                float* po = F.out + O_POOLP + ((size_t)(r >> 12) * POOLST + (t - (SEQ - POOLST))) * D + 8 * c8;
                *(f32x4*)po = (f32x4){a0[0], a0[1], a0[2], a0[3]} + *(const f32x4*)sh; *(f32x4*)(po + 4) = (f32x4){a0[4], a0[5], a0[6], a0[7]} + *(const f32x4*)(sh + 4); }
            if (t - w + 1 >= 0) {
                const u32x4 q = *(const u32x4*)(xg + (size_t)(r - w + 1) * D); const float rq = __builtin_amdgcn_rsqf(ssq[r - w + 1] * (1.f / D) + RMS_EPS);
                s[0] -= bflo(q.x) * rq; s[1] -= bfhi(q.x) * rq; s[2] -= bflo(q.y) * rq; s[3] -= bfhi(q.y) * rq; s[4] -= bflo(q.z) * rq; s[5] -= bfhi(q.z) * rq; s[6] -= bflo(q.w) * rq; s[7] -= bfhi(q.w) * rq; }
        }
    }
    const int gw = ded ? (smp_wave ? F.bid : DECB) : F.bid * NWAVES + F.wave, NGW = ded ? DECB : F.G * NWAVES;
    for (int seq = gw; seq < DECB; seq += NGW) {
        const float* mr = mod_l + (size_t)(NBATCH + seq) * NMOD;
        f32x4 h[4][4];
#pragma unroll
        for (int t = 0; t < 4; ++t) { float* xr = F.X + (size_t)(MP + seq * DECS + t) * D; float sq = 0.f;
#pragma unroll
            for (int j = 0; j < 4; ++j) { const int c = 4 * F.lane + 256 * j; f32x4 xv = *(const f32x4*)(xr + c);
#pragma unroll
                for (int ks = 0; ks < 8; ++ks) xv += *(const f32x4*)(F.SLAB + ((size_t)ks * MS + seq * DECS + t) * D + c);
                *(f32x4*)(xr + c) = xv; h[t][j] = xv; sq += (h[t][j].x * h[t][j].x + h[t][j].y * h[t][j].y) + (h[t][j].z * h[t][j].z + h[t][j].w * h[t][j].w); }
            const float rstd = __builtin_amdgcn_rsqf(wave_sum(sq) * (1.f / D) + RMS_EPS);
#pragma unroll
            for (int j = 0; j < 4; ++j) { const int c = 4 * F.lane + 256 * j; h[t][j] = h[t][j] * rstd * *(const f32x4*)(F.g_mix + D + c) * (*(const f32x4*)(mr + D + c) + 1.0f) + *(const f32x4*)(mr + c); } }
#pragma unroll
        for (int j = 0; j < 4; ++j) {
            const int c = 4 * F.lane + 256 * j, w = 2 << j;
            f32x4 ext[19];
#pragma unroll
            for (int i = 0; i < POOLST; ++i) ext[i] = *(const f32x4*)(F.state_pool + ((size_t)seq * POOLST + i) * D + c);
#pragma unroll
            for (int t = 0; t < 4; ++t) ext[POOLST + t] = h[t][j];
            const float iw = 1.0f / (float)w;
#pragma unroll
            for (int t = 0; t < 4; ++t) { f32x4 sm = {0.f, 0.f, 0.f, 0.f};
#pragma unroll
                for (int i = 0; i < 16; ++i) if (i < w) sm += ext[POOLST + t - i];
                const f32x4 p = sm * iw - h[t][j]; u32x2 o; o.x = pk2(p[0], p[1]); o.y = pk2(p[2], p[3]);
                *(u32x2*)(PB + (size_t)(MP + seq * DECS + t) * D + c) = o; }
#pragma unroll
            for (int i = 0; i < POOLST; ++i) *(f32x4*)(F.out + O_POOLS + ((size_t)seq * POOLST + i) * D + c) = ext[i + DECS];
        }
    }
}

__device__ __forceinline__ unsigned okey(float f) { const unsigned u = __float_as_uint(f); return (u & 0x80000000u) ? ~u : (u | 0x80000000u); }
__device__ __forceinline__ bf16x8 ld8_bf(const bf16_t* p) { return *(const bf16x8*)p; }
__device__ __forceinline__ bf16x8 ld8_f32(const float* p) { const f32x4 a = *(const f32x4*)p, b = *(const f32x4*)(p + 4); return pack8(a, b); }
__device__ __forceinline__ s16x4 vtr(const LAS unsigned char* p) { typedef short v4i16_t __attribute__((ext_vector_type(4))); return __builtin_bit_cast(s16x4, __builtin_amdgcn_ds_read_tr16_b64_v4i16((LAS v4i16_t*)p)); }

template <bool F32SRC>
__device__ __forceinline__ void attn_query(Frame& F, int lane, const LAS unsigned short* IL, LAS unsigned char* vst, int nsel, int qrow, int b, const int* pt, int seq, int gsel) {
    constexpr int NB = F32SRC ? 2 : 4;
    asm volatile("" : "+v"(lane));
    const int col = lane & 15, kq = lane >> 4;
    bf16x8 Bq[4];
#pragma unroll
    for (int c = 0; c < 4; ++c) { bf16x8 qv = (bf16x8){0, 0, 0, 0, 0, 0, 0, 0}; if (col < 4) qv = ld8_bf(F.QB + (size_t)qrow * D + (gsel * 4 + col) * HD + 32 * c + 8 * kq); Bq[c] = qv; }
    const int lrow = lane >> 2, lpc = lane & 3;
    const int psrc = (4 * col + kq) * 4;
    const char* kbase = (const char*)(F.KB + (size_t)b * SEQ * KVW + gsel * HD) + lpc * 16;
    unsigned koff[16]; const float* kptr[16];
#pragma unroll
    for (int t = 0; t < 16; ++t) {
        if (F32SRC) { const int key = IL[16 * t + col]; kptr[t] = (key < PAST ? F.cache_k + ((size_t)pt[key >> 7] * PAGE + (key & (PAGE - 1))) * KVW : F.out + O_KS + (size_t)(seq * DECS + key - PAST) * KVW) + gsel * HD + 8 * kq; }
        else { const int key = IL[16 * t + lrow]; koff[t] = (unsigned)key * (KVW * 2); } }
    bf16x8 kbuf[NB][4];
#define ATT_LOADU(u) do { _Pragma("unroll") for (int c_ = 0; c_ < 4; ++c_) \
        kbuf[(u) % NB][c_] = F32SRC ? ld8_f32(kptr[u] + 32 * c_) : ld8_bf((const bf16_t*)(kbase + koff[u] + c_ * 64)); } while (0)
#pragma unroll
    for (int u = 0; u < NB; ++u) ATT_LOADU(u);
    f32x4 S[16];
#pragma unroll
    for (int u = 0; u < 16; ++u) {
        f32x4 a = (f32x4){0.f, 0.f, 0.f, 0.f};
#pragma unroll
        for (int c = 0; c < 4; ++c) {
            bf16x8 kf = kbuf[u % NB][c];
            if (!F32SRC) { u32x4 w = __builtin_bit_cast(u32x4, kf);
                w.x = (unsigned)__builtin_amdgcn_ds_bpermute(psrc, (int)w.x); w.y = (unsigned)__builtin_amdgcn_ds_bpermute(psrc, (int)w.y);
                w.z = (unsigned)__builtin_amdgcn_ds_bpermute(psrc, (int)w.z); w.w = (unsigned)__builtin_amdgcn_ds_bpermute(psrc, (int)w.w);
                kf = __builtin_bit_cast(bf16x8, w); }
            a = __builtin_amdgcn_mfma_f32_16x16x32_bf16(kf, Bq[c], a, 0, 0, 0);
        }
        S[u] = a;
        if (u + NB < 16) ATT_LOADU(u + NB);
    }
#undef ATT_LOADU
    u32x4 R[2][4];
    const char* vbase = (const char*)(F.VB + (size_t)b * SEQ * KVW + gsel * HD) + (lane & 15) * 16;
#define ATT_LOADV(hb, blk) do { _Pragma("unroll") for (int ld_ = 0; ld_ < 4; ++ld_) { const int key_ = IL[32 * (blk) + 16 * (hb) + 4 * ld_ + (lane >> 4)]; \
        if (F32SRC) R[hb][ld_] = __builtin_bit_cast(u32x4, ld8_f32((key_ < PAST ? F.cache_v + ((size_t)pt[key_ >> 7] * PAGE + (key_ & (PAGE - 1))) * KVW : F.out + O_VS + (size_t)(seq * DECS + key_ - PAST) * KVW) + gsel * HD + 8 * (lane & 15))); \
        else R[hb][ld_] = *(const u32x4*)(vbase + (unsigned)key_ * (KVW * 2)); } } while (0)
    ATT_LOADV(0, 0); ATT_LOADV(1, 0);
    float mxs = -INFINITY;
#pragma unroll
    for (int t = 0; t < 16; ++t)
#pragma unroll
        for (int r = 0; r < 4; ++r) { const int p = 16 * t + 4 * kq + r; if (p >= nsel) S[t][r] = -INFINITY; mxs = fmaxf(mxs, S[t][r]); }
    mxs = fmaxf(mxs, __shfl_xor(mxs, 16)); mxs = fmaxf(mxs, __shfl_xor(mxs, 32));
    const float c2 = 0.08838834764831845f * 1.4426950408889634f;
    float lsum = 0.f;
#pragma unroll
    for (int t = 0; t < 16; ++t)
#pragma unroll
        for (int r = 0; r < 4; ++r) { const float p = __builtin_amdgcn_exp2f((S[t][r] - mxs) * c2); S[t][r] = p; lsum += p; }
    lsum += __shfl_xor(lsum, 16); lsum += __shfl_xor(lsum, 32);
    bf16x8 PA[8];
#pragma unroll
    for (int i = 0; i < 8; ++i) PA[i] = pack8(S[2 * i], S[2 * i + 1]);
    f32x4 O[8];
#pragma unroll
    for (int dt = 0; dt < 8; ++dt) O[dt] = (f32x4){0.f, 0.f, 0.f, 0.f};
    const int q_ = (lane & 15) >> 2, p_ = lane & 3;
    const int s0 = 4 * kq + q_;
#pragma unroll
    for (int i = 0; i < 8; ++i) {
#pragma unroll
        for (int hb = 0; hb < 2; ++hb) {
#pragma unroll
            for (int ld = 0; ld < 4; ++ld) { const int slot = 16 * hb + 4 * ld + (lane >> 4), ch = lane & 15;
                *(LAS u32x4*)(vst + slot * 256 + ((ch ^ ((slot & 7) << 1)) << 4)) = R[hb][ld]; }
            if (i + 1 < 8) { if (hb == 0) ATT_LOADV(0, i + 1); else ATT_LOADV(1, i + 1); }
        }
        asm volatile("" ::: "memory");
#pragma unroll
        for (int dt = 0; dt < 8; ++dt) {
            const int ch = dt * 2 + (p_ >> 1);
            const LAS unsigned char* a0 = vst + s0 * 256 + ((ch ^ ((s0 & 7) << 1)) << 4) + (p_ & 1) * 8;
            const s16x4 lo = vtr(a0), hi = vtr(a0 + 16 * 256);
            const bf16x8 bv = (bf16x8){lo[0], lo[1], lo[2], lo[3], hi[0], hi[1], hi[2], hi[3]};
            O[dt] = __builtin_amdgcn_mfma_f32_16x16x32_bf16(PA[i], bv, O[dt], 0, 0, 0);
        }
        asm volatile("" ::: "memory");
    }
#undef ATT_LOADV
    float inv[4];
#pragma unroll
    for (int h = 0; h < 4; ++h) inv[h] = __builtin_amdgcn_rcpf(__shfl(lsum, h));
    if (kq == 0) {
        bf16_t* ob = F.OB + (size_t)qrow * D + gsel * 4 * HD;
#pragma unroll
        for (int dt = 0; dt < 8; ++dt)
#pragma unroll
            for (int r = 0; r < 4; ++r) ob[r * HD + 16 * dt + col] = (bf16_t)(pk2(O[dt][r] * inv[r], 0.f) & 0xffffu);
    }
}

template <bool SAMPLE>
__device__ __forceinline__ void dsa_item(Frame& F, int item) {
    constexpr int NQ = SAMPLE ? 4 : 8, NG = SAMPLE ? 1 : 2, NREG = SAMPLE ? 33 : 64;
    int lane = F.lane; asm volatile("" : "+v"(lane));
    const int w = F.wave;
    LAS float* SC = (LAS float*)F.lds;
    LAS unsigned short* IDXL = (LAS unsigned short*)(F.lds + IDXL_OFF);
    const int seq = item;
    const int b = SAMPLE ? seq : (item & 3), t0 = SAMPLE ? PAST : (item >> 2) * 8;
    const int row0 = SAMPLE ? MP + seq * DECS : b * SEQ + t0;
    const int* pt = F.page_table + (SAMPLE ? seq * PAGES_PER_SEQ : 0);
    {
        const int r = lane & 31, hk = lane >> 5, hi = hk;
        const int q4 = (r >> 4) + 2 * ((r >> 2) & 1), head = (r & 3) + 4 * ((r >> 3) & 1);
        bf16x8 afr[NG][4]; float wiA[NG][8], wiB[NG][8];
        const float cs = 0.125f * 0.35355339059327373f;
#pragma unroll
        for (int G = 0; G < NG; ++G) {
#pragma unroll
            for (int c = 0; c < 4; ++c) afr[G][c] = ld8_bf(F.QIB + (size_t)(row0 + 4 * G + q4) * QIW + head * IDD + 16 * c + 8 * hk);
            const float* wa = F.WIF + (size_t)(row0 + 4 * G + 2 * hi) * 8;
#pragma unroll
            for (int h = 0; h < 8; ++h) { wiA[G][h] = wa[h] * cs; wiB[G][h] = wa[8 + h] * cs; }
        }
        const int nkt = SAMPLE ? 65 : (t0 + 8 + 31) / 32;
        auto load_tile = [&](bf16x8 (&fr)[4], int kt) {
            if (SAMPLE) {
                const int s_ = 32 * kt + r, sc = s_ < PAST + DECS - 1 ? s_ : PAST + DECS - 1;
                const int page = pt[kt < PAST / 32 ? (kt >> 2) : 0];
                const float* kp = kt < PAST / 32 ? F.cache_ki + ((size_t)page * PAGE + (sc & (PAGE - 1))) * IDD : F.out + O_KIS + (size_t)(seq * DECS + sc - PAST) * IDD;
#pragma unroll
                for (int c = 0; c < 4; ++c) fr[c] = ld8_f32(kp + 16 * c + 8 * hk);
            } else {
                const bf16_t* kp = F.KIB + ((size_t)(b * SEQ) / 32 + kt) * (32 * IDD) + (hk * 32 + r) * 8;
#pragma unroll
                for (int c = 0; c < 4; ++c) fr[c] = ld8_bf(kp + c * (2 * 32 * 8));
            }
        };
        auto do_tile = [&](const bf16x8 (&fr)[4], int kt) {
            const int s_ = 32 * kt + r;
#pragma unroll
            for (int G = 0; G < NG; ++G) {
                f32x16 acc;
#pragma unroll
                for (int i = 0; i < 16; ++i) acc[i] = 0.f;
#pragma unroll
                for (int c = 0; c < 4; ++c) acc = __builtin_amdgcn_mfma_f32_32x32x16_bf16(afr[G][c], fr[c], acc, 0, 0, 0);
                float sA = 0.f, sB = 0.f;
#pragma unroll
                for (int h = 0; h < 8; ++h) { sA += __builtin_amdgcn_fmed3f(acc[h], 0.f, __builtin_inff()) * wiA[G][h]; sB += __builtin_amdgcn_fmed3f(acc[8 + h], 0.f, __builtin_inff()) * wiB[G][h]; }
                SC[(4 * G + 2 * hi) * 4096 + s_] = sA + 0.0f; SC[(4 * G + 2 * hi + 1) * 4096 + s_] = sB + 0.0f;
            }
        };
        bf16x8 f0[4], f1[4];
        int kt = w;
        if (kt < nkt) load_tile(f0, kt);
        for (; kt < nkt; kt += 2 * NWAVES) {
            if (kt + NWAVES < nkt) load_tile(f1, kt + NWAVES);
            do_tile(f0, kt);
            if (kt + NWAVES < nkt) { if (kt + 2 * NWAVES < nkt) load_tile(f0, kt + 2 * NWAVES); do_tile(f1, kt + NWAVES); }
        }
    }
    __syncthreads();
    if (w < NQ) {
        asm volatile("" : "+v"(lane));
        const int qi = w;
        const int pos = t0 + qi, nvalid = pos + 1;
        const int nsel = nvalid < TOPK ? nvalid : TOPK;
        LAS unsigned short* IL = IDXL + w * 256;
        if (nvalid <= TOPK) {
#pragma unroll
            for (int i = 0; i < 4; ++i) { const int p = lane + 64 * i; IL[p] = (unsigned short)(p < nvalid ? p : 0); }
        } else {
            const LAS float* scl = SC + qi * 4096 + lane; asm volatile("" : "+v"(scl));
            constexpr int NCH = (NREG + 7) / 8;
            const int nch = (nvalid + 511) >> 9;
            unsigned u[NCH * 8]; unsigned mx = 0u;
#pragma unroll
            for (int c = 0; c < NCH; ++c) {
#pragma unroll
                for (int j = 0; j < 8; ++j) u[8 * c + j] = 0u;
                if (c < nch) {
#pragma unroll
                    for (int j = 0; j < 8; ++j) { const int s = 64 * (8 * c + j) + lane; const unsigned k = okey(scl[64 * (8 * c + j)]); u[8 * c + j] = s < nvalid ? k : 0u; mx = mx > u[8 * c + j] ? mx : u[8 * c + j]; }
                }
            }
            mx = wave_max_u(mx);
            LAS unsigned* hist = (LAS unsigned*)(F.lds + HIST_OFF) + w * 256;
            unsigned lo, wl, above = 0u, T, ngt;
            if (mx >= 0x80000000u + (1u << 25)) { lo = mx + 1u - (1u << 25); wl = 25u; } else { lo = 0u; wl = 32u; }
            for (;;) {
                const unsigned shift = wl > 8u ? wl - 8u : 0u;
                *(LAS u32x4*)(hist + 4 * lane) = (u32x4){0u, 0u, 0u, 0u};
#pragma unroll
                for (int c = 0; c < NCH; ++c) {
                    if (c < nch) {
#pragma unroll
                        for (int j = 0; j < 8; ++j) { const unsigned d = u[8 * c + j] - lo; const bool in = wl >= 32u ? true : (d >> wl) == 0u;
                            if (in) (void)__hip_atomic_fetch_add(hist + (d >> shift), 1u, __ATOMIC_RELAXED, __HIP_MEMORY_SCOPE_WORKGROUP); }
                    }
                }
                LDS_WAIT(); asm volatile("" ::: "memory");
                const u32x4 h4 = *(const LAS u32x4*)(hist + 4 * lane);
                const unsigned sl = (h4.x + h4.y) + (h4.z + h4.w);
                unsigned pre = sl;
#pragma unroll
                for (int o = 1; o < 64; o <<= 1) { const unsigned t = (unsigned)__shfl_up((int)pre, o); if (lane >= o) pre += t; }
                const unsigned total = (unsigned)__builtin_amdgcn_readlane((int)pre, 63);
                if (above + total < (unsigned)TOPK) { lo = 0u; wl = 32u; above = 0u; continue; }
                const unsigned suf = total - pre + sl;
                const unsigned long long bm = __ballot(above + suf >= (unsigned)TOPK);
                const int L = 63 - __builtin_clzll(bm);
                unsigned acc = above + suf - sl, bsel = 0u, csel = 0u, asel = 0u; bool fnd = false;
#pragma unroll
                for (int q = 3; q >= 0; --q) { const unsigned h = h4[q]; if (!fnd && acc + h >= (unsigned)TOPK) { bsel = 4u * (unsigned)lane + (unsigned)q; csel = h; asel = acc; fnd = true; } acc += h; }
                const unsigned bstar = (unsigned)__builtin_amdgcn_readlane((int)bsel, L), cnt_b = (unsigned)__builtin_amdgcn_readlane((int)csel, L);
                above = (unsigned)__builtin_amdgcn_readlane((int)asel, L);
                lo += bstar << shift;
                if (above + cnt_b == (unsigned)TOPK) { T = lo - 1u; ngt = (unsigned)TOPK; break; }
                if (shift == 0u) { T = lo; ngt = above; break; }
                wl = shift;
            }
            const unsigned need_eq = (unsigned)TOPK - ngt;
            unsigned base = 0u, eqb = 0u;
#pragma unroll
            for (int c = 0; c < NCH; ++c) {
                if (c < nch) {
#pragma unroll
                    for (int j = 0; j < 8; ++j) {
                        const int i = 8 * c + j;
                        const bool gt = u[i] > T, eq = u[i] == T;
                        const unsigned long long be = __ballot(eq);
                        const unsigned er = eqb + __builtin_amdgcn_mbcnt_hi((unsigned)(be >> 32), __builtin_amdgcn_mbcnt_lo((unsigned)be, 0u));
                        const bool sel = gt || (eq && er < need_eq);
                        const unsigned long long bs = __ballot(sel);
                        const unsigned p = base + __builtin_amdgcn_mbcnt_hi((unsigned)(bs >> 32), __builtin_amdgcn_mbcnt_lo((unsigned)bs, 0u));
                        if (sel && p < (unsigned)TOPK) IL[p] = (unsigned short)(64 * i + lane);
                        base += (unsigned)__popcll(bs); eqb += (unsigned)__popcll(be);
                    }
                }
            }
        }
        LDS_WAIT(); asm volatile("" ::: "memory");
        *(u32x2*)(F.ILG + (size_t)(row0 + qi) * TOPK + 4 * lane) = *(const LAS u32x2*)(IL + 4 * lane);
    }
    __syncthreads();
}
__device__ __forceinline__ void dsa_select_phase(Frame& F) {
    for (int k = F.bid; k < MP / 8; k += F.G) { const int kk = ((k >> 8) & 1) ? (k ^ 255) : k; dsa_item<false>(F, kk); }
    for (int s = F.bid; s < DECB; s += F.G) dsa_item<true>(F, s);
}
__device__ __forceinline__ void dsa_attn_phase(Frame& F, unsigned* bar, volatile LAS unsigned* st) {
    int lane = F.lane; asm volatile("" : "+v"(lane));
    const int w = F.wave;
    LAS unsigned short* IL = (LAS unsigned short*)(F.lds + IDXL_OFF) + w * 256;
    LAS unsigned char* vst = F.lds + w * 8192;
    if (F.tid == 0) {
        unsigned ok = 1u, nx = 0u, vx = 0u; const unsigned x = st[3];
        for (unsigned j = 0; j < 16; ++j) { const unsigned c = xb_ld(&bar[XB_XCNT(j)]); if (c) { if (c != 32u) ok = 0u; if (j < x) ++vx; ++nx; } }
        if (nx != 8u || F.G != 256) ok = 0u;
        st[4] = ok; st[5] = vx;
    }
    __syncthreads();
    const bool xok = st[4] != 0u;
    const int vx = xok ? (int)st[5] : (F.bid & 7), rk = xok ? (int)st[2] : (F.bid >> 3);
    if (F.G == 256) {
        const int b = vx >> 1, g = vx & 1, wv = rk * 8 + w;
        for (int i = 0; i < 16; ++i) {
            const int t = wv + 256 * i, qrow = b * SEQ + t;
            *(LAS u32x2*)(IL + 4 * lane) = *(const u32x2*)(F.ILG + (size_t)qrow * TOPK + 4 * lane);
            attn_query<false>(F, lane, IL, vst, t + 1 < TOPK ? t + 1 : TOPK, qrow, b, nullptr, 0, g);
        }
    } else {
        for (int task = F.bid * NWAVES + w; task < MP * 2; task += F.G * NWAVES) {
            const int qrow = task >> 1, g = task & 1, b = qrow >> 12, t = qrow & (SEQ - 1);
            *(LAS u32x2*)(IL + 4 * lane) = *(const u32x2*)(F.ILG + (size_t)qrow * TOPK + 4 * lane);
            attn_query<false>(F, lane, IL, vst, t + 1 < TOPK ? t + 1 : TOPK, qrow, b, nullptr, 0, g);
        }
    }
    if (w < 4) {
        for (int task = F.bid * 4 + w; task < MS * 2; task += F.G * 4) {
            const int q = task >> 1, g = task & 1, seq = q >> 2, qrow = MP + q;
            *(LAS u32x2*)(IL + 4 * lane) = *(const u32x2*)(F.ILG + (size_t)qrow * TOPK + 4 * lane);
            attn_query<true>(F, lane, IL, vst, TOPK, qrow, 0, F.page_table + seq * PAGES_PER_SEQ, seq, g);
        }
    }
}

__global__ void __launch_bounds__(NTHREADS, 2) fwd_megakernel(Params P) {
    extern __shared__ __attribute__((aligned(16))) unsigned char lds_raw[];
    Frame F;
#define BUILD_FRAME() do { \
    int tid_ = threadIdx.x; asm volatile("" : "+v"(tid_)); \
    unsigned char* ws_ = as_global(P.ws); float* out_ = as_global(P.out); \
    F.lds = (LAS unsigned char*)lds_raw; \
    F.tid = tid_; F.lane = F.tid & 63; F.wave = __builtin_amdgcn_readfirstlane(F.tid >> 6); F.G = gridDim.x; F.bid = blockIdx.x; \
    F.x_p = as_global(P.in[0]); F.x_s = as_global(P.in[1]); F.cache_k = as_global(P.in[2]); F.cache_v = as_global(P.in[3]); F.cache_ki = as_global(P.in[4]); F.state_pool = as_global(P.in[5]); F.page_table = as_global((const int*)P.in[6]); \
    F.c_p = as_global(P.in[7]); F.c_s = as_global(P.in[8]); F.g_mix = as_global(P.in[9]); F.g_ffn = as_global(P.in[10]); F.w_mod = as_global(P.in[11]); F.b_mod = as_global(P.in[12]); F.w_in = as_global(P.in[13]); F.w_o = as_global(P.in[14]); \
    F.pool_w = as_global(P.in[15]); F.pool_scale = as_global(P.in[16]); F.w_up = as_global(P.in[17]); F.w_down = as_global(P.in[18]); F.g_final = as_global(P.in[19]); \
    F.out = out_; F.ws = ws_; \
    F.MOD = (float*)(ws_ + WS_MOD); F.SILU = (bf16_t*)(ws_ + WS_SILU); F.WIN = (bf16_t*)(ws_ + WS_WIN); F.WO = (bf16_t*)(ws_ + WS_WO); F.WPOOL = (bf16_t*)(ws_ + WS_WPOOL); \
    F.WUP = (bf16_t*)(ws_ + WS_WUP); F.WDN = (bf16_t*)(ws_ + WS_WDN); F.HB = (bf16_t*)(ws_ + WS_HB); F.QB = (bf16_t*)(ws_ + WS_QB); F.KB = (bf16_t*)(ws_ + WS_KB); F.VB = (bf16_t*)(ws_ + WS_VB); \
    F.QIB = (bf16_t*)(ws_ + WS_QIB); F.KIB = (bf16_t*)(ws_ + WS_KIB); F.WIF = (float*)(ws_ + WS_WIF); F.OB = (bf16_t*)(ws_ + WS_OB); F.X = (float*)(ws_ + WS_X); F.UB = (bf16_t*)(ws_ + WS_UB); F.ILG = (unsigned short*)(ws_ + WS_IL); F.GS = (float*)(ws_ + WS_GS); F.BIAS = (float*)(ws_ + WS_BIAS); F.SHB = (bf16_t*)(ws_ + WS_SHB); F.SLAB = (float*)(ws_ + WS_SLAB); F.SSQ = (float*)(ws_ + WS_CTL) + CW_SSQ; \
    mod0 = F.MOD; mod1 = F.MOD + (size_t)NBROW * NMOD; } while (0)
    const float* mod0; const float* mod1;
    unsigned char* ws = P.ws;
    volatile LAS unsigned* MISC = (volatile LAS unsigned*)((LAS unsigned char*)lds_raw + MISC_OFF);
    for (int u = threadIdx.x; u < 64; u += NTHREADS) MISC[u] = 0u;
    __syncthreads();
    XcdBarrier bar = xcd_barrier_post((unsigned*)(ws + WS_CTL) + CW_BAR, MISC + 8);
#define GRID_BAR() do { xcd_barrier(bar); BUILD_FRAME(); } while (0)

    BUILD_FRAME();
    p0(F);
    cg::this_grid().sync();
    BUILD_FRAME();
    rowpass<3>(F, F.x_p, F.x_s, F.g_mix, mod0, 0, 1, F.HB);
    GRID_BAR();
    {   pg8::Gemm g{F.HB, F.WIN, MT, NPROJ, D, D, D, 0}; pg8::MixOrder S; S.init(MP, MS, NPROJ, D, 1, F.G, F.bid);
        EpiProj E{F.QB, F.KB, F.VB, F.QIB, F.KIB, F.WIF, F.out};
        pg8::gemm_phase<EpiProj, pg8::MixOrder, true>(F.lds, g, S, E); }
    {   pg8::Gemm g{F.SHB, F.WUP, 512, 2 * DFF, D, D, D, 0}; BiasOrder S{F.bid};
        EpiBias E{F.BIAS};
        pg8::gemm_phase<EpiBias, BiasOrder, true>(F.lds, g, S, E); }
    GRID_BAR();
    dsa_select_phase(F);
    GRID_BAR();
    dsa_attn_phase(F, (unsigned*)(ws + WS_CTL) + CW_BAR, MISC + 8);
    GRID_BAR();
    {   pg8::Gemm g{F.OB, F.WO, MT, D, D, D, D, 0}; pg8::MixOrder S; S.init(MP, MS, D, D, 1, F.G, F.bid);
        EpiRes<1> E{F.x_p, F.x_s, F.X, mod0 + 2 * D, nullptr, F.GS, F.HB, F.SSQ, false, nullptr};
        pg8::gemm_phase<EpiRes<1>, pg8::MixOrder, true>(F.lds, g, S, E); }
    GRID_BAR();
    {   pg8::Gemm g{F.HB, F.WUP, MT, DFF, D, D, D, 0}; pg8::MixOrder S; S.init(MP, MS, DFF, D, 1, F.G, F.bid);
        EpiUp E{F.UB, F.SSQ, F.BIAS};
        pg8::gemm_phase<EpiUp, pg8::MixOrder, true>(F.lds, g, S, E); }
    GRID_BAR();
    {   pg8::Gemm g{F.UB, F.WDN, MT, D, DFF, DFF, DFF, 0}; pg8::MixOrder S; S.init(MP, MS, D, DFF, 8, F.G, F.bid);
        EpiRes<1> E{F.X, F.X + (size_t)MP * D, F.X, mod0 + 5 * D, nullptr, F.GS + (size_t)NBROW * D, F.HB, F.SSQ + MT, true, F.SLAB};
        pg8::gemm_phase<EpiRes<1>, pg8::MixOrder, true>(F.lds, g, S, E); }
    GRID_BAR();
    poolpass(F, F.HB, F.SSQ + MT, mod1, F.OB);
    GRID_BAR();
    {   pg8::Gemm g{F.OB, F.WPOOL, MT, D, 256, D, 256, 256}; pg8::MixOrder S; S.init(MP, MS, D, 256, 1, F.G, F.bid);
        EpiRes<1> E{F.X, F.X + (size_t)MP * D, F.X, mod1 + 2 * D, F.pool_scale, F.GS + (size_t)2 * NBROW * D, F.HB, F.SSQ + 2 * MT, true, nullptr};
        pg8::gemm_phase<EpiRes<1>, pg8::MixOrder, true>(F.lds, g, S, E); }
    GRID_BAR();
    {   pg8::Gemm g{F.HB, F.WUP + (size_t)D * DFF, MT, DFF, D, D, D, 0}; pg8::MixOrder S; S.init(MP, MS, DFF, D, 1, F.G, F.bid);
        EpiUp E{F.UB, F.SSQ + 2 * MT, F.BIAS + (size_t)256 * DFF};
        pg8::gemm_phase<EpiUp, pg8::MixOrder, true>(F.lds, g, S, E); }
    GRID_BAR();
    {   pg8::Gemm g{F.UB, F.WDN + (size_t)D * DFF, MT, D, DFF, DFF, DFF, 0}; pg8::MixOrder S; S.init(MP, MS, D, DFF, 8, F.G, F.bid);
        EpiRes<2> E{F.X, F.X + (size_t)MP * D, F.X, mod1 + 5 * D, nullptr, nullptr, nullptr, F.SSQ + 3 * MT, true, F.SLAB};
        pg8::gemm_phase<EpiRes<2>, pg8::MixOrder, true>(F.lds, g, S, E); }
    GRID_BAR();
    finalpass(F);
}

extern "C" void kernel_launch(void* const* d_in, const int* in_sizes, int n_in, void* d_out, int out_size, void* d_ws, size_t ws_size, hipStream_t stream) {
    static int grid = 0;
    if (grid == 0) {
        if (n_in != 20 || (size_t)out_size != O_END || ws_size < WS_END) { fprintf(stderr, "kernel_launch: unexpected shapes (n_in %d out %d ws %zu)\n", n_in, out_size, ws_size); grid = -1; return; }
        int dev = 0, cus = 0, per_cu = 0;
        if (hipGetDevice(&dev) != hipSuccess || hipDeviceGetAttribute(&cus, hipDeviceAttributeMultiprocessorCount, dev) != hipSuccess) { grid = -1; return; }
        if (hipFuncSetAttribute((const void*)fwd_megakernel, hipFuncAttributeMaxDynamicSharedMemorySize, LDS_BYTES) != hipSuccess) { fprintf(stderr, "kernel_launch: hipFuncSetAttribute failed\n"); grid = -1; return; }
        if (hipOccupancyMaxActiveBlocksPerMultiprocessor(&per_cu, (const void*)fwd_megakernel, NTHREADS, LDS_BYTES) != hipSuccess || per_cu < 1) { fprintf(stderr, "kernel_launch: occupancy query failed (%d)\n", per_cu); (void)hipGetLastError(); grid = -1; return; }
        grid = cus;
    }
    if (grid < 0) return;
    (void)hipMemsetAsync((char*)d_ws + WS_CTL, 0, CTL_ZERO_BYTES, stream);
    Params p{};
    for (int i = 0; i < 20; ++i) p.in[i] = (const float*)d_in[i];
    p.out = (float*)d_out; p.ws = (unsigned char*)d_ws;
    void* args[] = {&p};
    hipError_t e = hipLaunchCooperativeKernel((const void*)fwd_megakernel, dim3(grid), dim3(NTHREADS), args, LDS_BYTES, stream);
    if (e != hipSuccess) fprintf(stderr, "cooperative launch failed: %s (grid %d)\n", hipGetErrorString(e), grid);
}
```

```cpp
#include <hip/hip_runtime.h>
#include <hip/hip_cooperative_groups.h>
#include <cstdio>
#include <cstdint>
namespace cg = cooperative_groups;

#define LAS __attribute__((address_space(3)))
typedef unsigned short bf16_t;
typedef short bf16x8 __attribute__((ext_vector_type(8)));
typedef short s16x4 __attribute__((ext_vector_type(4)));
typedef float f32x2 __attribute__((ext_vector_type(2)));
typedef float f32x4 __attribute__((ext_vector_type(4)));
typedef float f32x16 __attribute__((ext_vector_type(16)));
typedef unsigned u32x2 __attribute__((ext_vector_type(2)));
typedef unsigned u32x4 __attribute__((ext_vector_type(4)));
typedef __bf16 bf16x2_t __attribute__((ext_vector_type(2)));

constexpr int D = 1024, NBATCH = 4, SEQ = 4096, MP = NBATCH * SEQ, DECB = 128, DECS = 4, MS = DECB * DECS, MT = MP + MS;
constexpr int PAST = 2048, PAGE = 128, PAGES_PER_SEQ = 16;
constexpr int NH = 8, HD = 128, NKV = 2, KVW = NKV * HD, IH = 8, IDD = 64, QIW = IH * IDD, TOPK = 256;
constexpr int DFF = 4096, DPROJ = 2120, NPROJ = 2304, NMOD = 6 * D, NBROW = NBATCH + DECB;
constexpr int POOLST = 15;
constexpr float RMS_EPS = 1e-6f;
constexpr size_t O_YP = 0, O_YS = O_YP + (size_t)MP * D, O_KP = O_YS + (size_t)MS * D, O_VP = O_KP + (size_t)MP * KVW, O_KIP = O_VP + (size_t)MP * KVW,
                 O_POOLP = O_KIP + (size_t)MP * IDD, O_KS = O_POOLP + (size_t)NBATCH * POOLST * D, O_VS = O_KS + (size_t)MS * KVW, O_KIS = O_VS + (size_t)MS * KVW,
                 O_POOLS = O_KIS + (size_t)MS * IDD, O_END = O_POOLS + (size_t)DECB * POOLST * D;
constexpr size_t MiB = 1u << 20;
constexpr size_t WS_CTL = 0, CTL_ZERO_BYTES = 1 * MiB, WS_MOD = 1 * MiB, WS_SILU = 8 * MiB, WS_WIN = 9 * MiB, WS_WO = 14 * MiB, WS_WPOOL = 16 * MiB, WS_WUP = 17 * MiB,
                 WS_WDN = 33 * MiB, WS_HB = 49 * MiB, WS_QB = 82 * MiB, WS_KB = 115 * MiB, WS_VB = 124 * MiB, WS_QIB = 133 * MiB, WS_KIB = 150 * MiB, WS_WIF = 153 * MiB,
                 WS_OB = 154 * MiB, WS_X = 187 * MiB, WS_UB = 253 * MiB, WS_IL = 385 * MiB, WS_GS = 394 * MiB, WS_SHB = 396 * MiB, WS_BIAS = 397 * MiB, WS_SLAB = 405 * MiB, WS_END = 421 * MiB;
constexpr int CW_BAR = 4096, CW_SSQ = 16384;
static_assert((CW_SSQ + 4 * MT) * 4 <= (int)CTL_ZERO_BYTES, "CTL map");
constexpr int RING_BYTES = 131072, IDXL_OFF = RING_BYTES, MISC_OFF = IDXL_OFF + 4096, HIST_OFF = MISC_OFF + 256, LDS_BYTES = 147456;
static_assert(HIST_OFF + 8 * 1024 <= LDS_BYTES, "LDS map");
constexpr int NWAVES = 8, NTHREADS = 512;

#define GAS __attribute__((address_space(1)))
template <class T> __device__ __forceinline__ T* as_global(T* p) { GAS T* g = (GAS T*)p; asm volatile("" : "+s"(g)); return (T*)g; }
__device__ __forceinline__ unsigned pk2(float lo, float hi) { f32x2 v = {lo, hi}; bf16x2_t b = __builtin_convertvector(v, bf16x2_t); return __builtin_bit_cast(unsigned, b); }
__device__ __forceinline__ float bflo(unsigned u) { return __uint_as_float(u << 16); }
__device__ __forceinline__ float bfhi(unsigned u) { return __uint_as_float(u & 0xffff0000u); }
__device__ __forceinline__ bf16x8 pack8(f32x4 a, f32x4 b) { u32x4 w; w.x = pk2(a[0], a[1]); w.y = pk2(a[2], a[3]); w.z = pk2(b[0], b[1]); w.w = pk2(b[2], b[3]); return __builtin_bit_cast(bf16x8, w); }
#define LDS_WAIT() asm volatile("s_waitcnt lgkmcnt(0)" ::: "memory")
#define VM_WAIT() asm volatile("s_waitcnt vmcnt(0)" ::: "memory")

namespace pg8 {
constexpr int BM = 256, BK = 64, HALF = 128, HTB = HALF * BK * 2, STAGE_BYTES = 8 * HTB, NXCD = 8, WGM = 8;
__host__ __device__ __forceinline__ int lds_byte(int r, int c) { const int st = (r >> 4) * 2 + (c >> 5), rr = r & 15, cc = c & 31, ob = rr * 64 + cc * 2; return st * 1024 + (ob ^ (((ob >> 9) & 1) << 5)); }
__host__ __device__ __forceinline__ void stage_rc(int b, int& R, int& C) { const int st = b / 1024, sb = b % 1024, swz = sb ^ (((sb >> 9) & 1) << 5); R = (st >> 1) * 16 + swz / 64; C = (st & 1) * 32 + (swz % 64) / 2; }
__host__ __device__ __forceinline__ int perm32(int rho) { const int n = rho >> 4, i = rho & 15; return 8 * (i >> 2) + 4 * n + (i & 3); }
struct Unit { int pm, pn, k0, nt; bool atomic; };
struct Gemm { const bf16_t* A; const bf16_t* Bt; int M, N, K, lda, ldb, acol; };
struct MixOrder {
    int nMp, nMs, nN, nP, nS, S, ntFull, G, c;
    __device__ void init(int Mp, int Ms, int N, int K, int S_, int G_, int c_) { nMp = Mp / BM; nMs = Ms / BM; nN = N / BM; nP = nMp * nN; S = S_; nS = nMs * nN * S; ntFull = K / BK; G = G_; c = c_; }
    __device__ bool next(int i, Unit& u) const {
        const long L = (long)i * G + c; if (L >= nP + nS) return false;
        if (L < nP) {
            int wgid = (int)L; { const int q = nP / NXCD, r = nP % NXCD, xcd = wgid % NXCD, off = wgid / NXCD; wgid = (xcd < r ? xcd * (q + 1) : r * (q + 1) + (xcd - r) * q) + off; }
            const int nig = WGM * nN, gid = wgid / nig, fm = gid * WGM, gsz = (nMp - fm) < WGM ? (nMp - fm) : WGM;
            u.pm = fm + ((wgid % nig) % gsz); u.pn = (wgid % nig) / gsz; u.k0 = 0; u.nt = ntFull; u.atomic = false;
        } else {
            const int s_ = (int)L - nP, ks = s_ % S, q = s_ / S;
            u.pn = q % nN; u.pm = nMp + q / nN; u.nt = ntFull / S; u.k0 = ks * u.nt; u.atomic = S > 1;
        }
        return true;
    }
    __device__ __forceinline__ void a_ready(const Unit&) const {}
    __device__ __forceinline__ void done(const Unit&) const {}
};

template <class Epi, class Sched, bool ALIGN_EPI>
__device__ __forceinline__ void gemm_phase(LAS unsigned char* lds, const Gemm g, const Sched& S, const Epi& E) {
    int tid_ = threadIdx.x; asm volatile("" : "+v"(tid_));
    const int tid = tid_, wid = __builtin_amdgcn_readfirstlane(tid >> 6), lane = tid & 63, wr = wid >> 2, wc = wid & 3, fr = lane & 15, fq = lane >> 4;
    unsigned voffA[2], voffB[2];
#pragma unroll
    for (int i = 0; i < 2; ++i) { int R, C; stage_rc(tid * 16 + i * 8192, R, C); const int Rb = Epi::PERM ? ((R & ~31) + perm32(R & 31)) : R;
        voffA[i] = (unsigned)(R * g.lda + C) * 2u; voffB[i] = (unsigned)(Rb * g.ldb + C) * 2u; }
    const size_t kstep = (size_t)(BK * 2);
    const size_t hstepA = (size_t)HALF * g.lda * 2, hstepB = (size_t)HALF * g.ldb * 2;
    const size_t tstepA = 2 * hstepA, tstepB = 2 * hstepB;
    const unsigned ldsw = (unsigned)wid * 1024u;
    const int aoff = lds_byte(wr * 64 + fr, fq * 8), boff = lds_byte(wc * 32 + fr, fq * 8);
#define PG8_SA(b, h) (((b) * 2 + (h)) * HTB)
#define PG8_SB(b, h) ((4 + (b) * 2 + (h)) * HTB)
#define PG8_STAGE(bufoff, gbase, voff) do { _Pragma("unroll") for (int _i = 0; _i < 2; ++_i) \
        __builtin_amdgcn_global_load_lds((const unsigned*)((const char*)(gbase) + (voff)[_i]), (LAS unsigned*)(lds + (bufoff) + ldsw + _i * 8192), 16, 0, 0); } while (0)
#define PG8_LDA(dst, b, h) do { _Pragma("unroll") for (int m = 0; m < 4; ++m) _Pragma("unroll") for (int k = 0; k < 2; ++k) dst[m][k] = *(const LAS bf16x8*)(lds + PG8_SA(b, h) + aoff + m * 2048 + k * 1024); } while (0)
#define PG8_LDB(dst, b, h) do { _Pragma("unroll") for (int n = 0; n < 2; ++n) _Pragma("unroll") for (int k = 0; k < 2; ++k) dst[n][k] = *(const LAS bf16x8*)(lds + PG8_SB(b, h) + boff + n * 2048 + k * 1024); } while (0)
#define PG8_MMA(ai, bj, At, Bt) do { __builtin_amdgcn_s_setprio(1); _Pragma("unroll") for (int m = 0; m < 4; ++m) _Pragma("unroll") for (int n = 0; n < 2; ++n) _Pragma("unroll") for (int k = 0; k < 2; ++k) \
        acc[ai][bj][m][n] = __builtin_amdgcn_mfma_f32_16x16x32_bf16(Bt[n][k], At[m][k], acc[ai][bj][m][n], 0, 0, 0); __builtin_amdgcn_s_setprio(0); } while (0)
#define PG8_WAIT_V(n) asm volatile("s_waitcnt vmcnt(" #n ")" ::: "memory")
#define PG8_WAIT_L(n) asm volatile("s_waitcnt lgkmcnt(" #n ")" ::: "memory")
#define PG8_BAR __builtin_amdgcn_s_barrier()
#define PG8_SCHED __builtin_amdgcn_sched_barrier(0)
#define PG8_UA(u) ((const char*)g.A + (size_t)(u).pm * tstepA + (size_t)(u).pn * (size_t)g.acol * 2 + (size_t)(u).k0 * kstep)
#define PG8_UB(u) ((const char*)g.Bt + (size_t)(u).pn * tstepB + (size_t)(u).k0 * kstep)
    Unit cur, nxt; int ui = 0;
    if (!S.next(0, cur)) return;
    f32x4 acc[2][2][4][2];
#pragma unroll
    for (int a = 0; a < 2; ++a)
#pragma unroll
        for (int b = 0; b < 2; ++b)
#pragma unroll
            for (int m = 0; m < 4; ++m)
#pragma unroll
                for (int n = 0; n < 2; ++n) acc[a][b][m][n] = (f32x4){0.f, 0.f, 0.f, 0.f};
    bf16x8 At[4][2], B0[2][2], B1[2][2];
    const char* cA = PG8_UA(cur); const char* cB = PG8_UB(cur);
    S.a_ready(cur);
    PG8_STAGE(PG8_SB(0, 0), cB, voffB); PG8_STAGE(PG8_SB(0, 1), cB + hstepB, voffB); PG8_STAGE(PG8_SA(0, 0), cA, voffA); PG8_STAGE(PG8_SA(0, 1), cA + hstepA, voffA);
    if (wr == 1) PG8_BAR;
    PG8_WAIT_V(2); PG8_BAR;
    PG8_STAGE(PG8_SB(1, 0), cB + kstep, voffB); PG8_STAGE(PG8_SA(1, 0), cA + kstep, voffA); PG8_STAGE(PG8_SB(1, 1), cB + hstepB + kstep, voffB);
    PG8_WAIT_V(6); PG8_BAR;
    for (;;) {
        const bool has_next = S.next(ui + 1, nxt);
        const char* nA = has_next ? PG8_UA(nxt) : cA; const char* nB = has_next ? PG8_UB(nxt) : cB;
        const int nt = cur.nt;
        for (int t = 0; t < nt; t += 2) {
            const bool last = (t == nt - 2);
            const char* a1 = cA + (size_t)(t + 1) * kstep;
            const char* a2 = last ? nA : cA + (size_t)(t + 2) * kstep; const char* b2 = last ? nB : cB + (size_t)(t + 2) * kstep;
            const char* a3 = a2 + kstep; const char* b3 = b2 + kstep;
            if (last && has_next) S.a_ready(nxt);
            PG8_LDB(B0, 0, 0); PG8_LDB(B1, 0, 1); PG8_SCHED; PG8_LDA(At, 0, 0); PG8_STAGE(PG8_SA(1, 1), a1 + hstepA, voffA);
            PG8_WAIT_V(8); PG8_WAIT_L(0); PG8_BAR; PG8_MMA(0, 0, At, B0); PG8_MMA(0, 1, At, B1); PG8_BAR; PG8_SCHED;
            PG8_LDA(At, 0, 1); PG8_STAGE(PG8_SB(0, 0), b2, voffB); PG8_STAGE(PG8_SB(0, 1), b2 + hstepB, voffB); PG8_STAGE(PG8_SA(0, 0), a2, voffA);
            PG8_WAIT_V(8); PG8_WAIT_L(0); PG8_BAR; PG8_MMA(1, 0, At, B0); PG8_MMA(1, 1, At, B1); PG8_BAR; PG8_SCHED;
            PG8_LDB(B0, 1, 0); PG8_LDB(B1, 1, 1); PG8_SCHED; PG8_LDA(At, 1, 0); PG8_STAGE(PG8_SA(0, 1), a2 + hstepA, voffA);
            PG8_WAIT_V(8); PG8_WAIT_L(0); PG8_BAR; PG8_MMA(0, 0, At, B0); PG8_MMA(0, 1, At, B1); PG8_BAR; PG8_SCHED;
            PG8_LDA(At, 1, 1); PG8_STAGE(PG8_SB(1, 0), b3, voffB); PG8_STAGE(PG8_SB(1, 1), b3 + hstepB, voffB); PG8_STAGE(PG8_SA(1, 0), a3, voffA);
            PG8_WAIT_V(8); PG8_WAIT_L(0); PG8_BAR; PG8_MMA(1, 0, At, B0); PG8_MMA(1, 1, At, B1); PG8_BAR; PG8_SCHED;
        }
        if constexpr (ALIGN_EPI) { if (wr == 0) PG8_BAR; }
        typename Epi::Pre pre;
        E.prefetch(pre, cur, wr, wc, lane >> 2, lane & 3);
        {
            const int psrc = ((lane >> 2) + 16 * (lane & 3)) * 4;
#pragma unroll
            for (int a = 0; a < 2; ++a)
#pragma unroll
                for (int b = 0; b < 2; ++b)
#pragma unroll
                    for (int m = 0; m < 4; ++m)
#pragma unroll
                        for (int n = 0; n < 2; ++n)
                        { const f32x4 v_ = acc[a][b][m][n]; f32x4 r_;
                            r_.x = __int_as_float(__builtin_amdgcn_ds_bpermute(psrc, __float_as_int(v_.x))); r_.y = __int_as_float(__builtin_amdgcn_ds_bpermute(psrc, __float_as_int(v_.y)));
                            r_.z = __int_as_float(__builtin_amdgcn_ds_bpermute(psrc, __float_as_int(v_.z))); r_.w = __int_as_float(__builtin_amdgcn_ds_bpermute(psrc, __float_as_int(v_.w)));
                            acc[a][b][m][n] = r_; }
        }
        E(acc, pre, cur, wr, wc, lane >> 2, lane & 3); S.done(cur);
        if (!has_next) break;
#pragma unroll
        for (int a = 0; a < 2; ++a)
#pragma unroll
            for (int b = 0; b < 2; ++b)
#pragma unroll
                for (int m = 0; m < 4; ++m)
#pragma unroll
                    for (int n = 0; n < 2; ++n) acc[a][b][m][n] = (f32x4){0.f, 0.f, 0.f, 0.f};
        cur = nxt; cA = nA; cB = nB; ++ui;
        if constexpr (ALIGN_EPI) { if (wr == 1) PG8_BAR; }
    }
    PG8_WAIT_V(0);
    if constexpr (!ALIGN_EPI) { if (wr == 0) PG8_BAR; }
    PG8_BAR;
#undef PG8_SA
#undef PG8_SB
#undef PG8_STAGE
#undef PG8_LDA
#undef PG8_LDB
#undef PG8_MMA
#undef PG8_WAIT_V
#undef PG8_WAIT_L
#undef PG8_BAR
#undef PG8_SCHED
#undef PG8_UA
#undef PG8_UB
}
}

#define XB_TMO      128
#define XB_XCNT(j)  (256  + 64 * (j))
#define XB_XSUB(j)  (1280 + 64 * (j))
#define XB_XGEN(j)  (2304 + 64 * (j))
#define XB_TOP      3328
#define XB_TOPGEN   3392
#define XCD_BAR_WORDS 3456
#define XB_SPIN_CAP (1u << 18)
__device__ __forceinline__ unsigned xb_ld(unsigned* p)              { return __hip_atomic_load(p, __ATOMIC_RELAXED, __HIP_MEMORY_SCOPE_AGENT); }
__device__ __forceinline__ unsigned xb_add(unsigned* p, unsigned v) { return __hip_atomic_fetch_add(p, v, __ATOMIC_RELAXED, __HIP_MEMORY_SCOPE_AGENT); }
__device__ __forceinline__ unsigned xb_xcc_id() { return (unsigned)__builtin_amdgcn_s_getreg((3 << 11) | 20) & 0xFu; }
#define XB_SPIN(cond, bar) do { unsigned _sp = 0; while (cond) { __builtin_amdgcn_s_sleep(1); \
    if ((++_sp & 255u) == 0u) { if (xb_ld(&(bar)[XB_TMO])) break; if (_sp > XB_SPIN_CAP) { atomicAdd(&(bar)[XB_TMO], 1u); break; } } } } while (0)
struct XcdBarrier { unsigned* bar; unsigned x; volatile LAS unsigned* st; };
__device__ __forceinline__ XcdBarrier xcd_barrier_post(unsigned* bar, volatile LAS unsigned* st) {
    XcdBarrier b; b.bar = bar; b.x = xb_xcc_id(); b.st = st;
    if (threadIdx.x == 0) { st[2] = xb_add(&bar[XB_XCNT(b.x)], 1u); st[3] = b.x; }
    return b;
}
__device__ __forceinline__ void xcd_barrier_complete(unsigned* bar, unsigned x, unsigned& nloc, unsigned& nx) {
    const unsigned G = gridDim.x * gridDim.y * gridDim.z;
    unsigned sum, cnt, mine, sp = 0u;
    for (;;) {
        sum = 0u; cnt = 0u; mine = 0u;
#pragma unroll
        for (unsigned j = 0; j < 16; ++j) { const unsigned c = xb_ld(&bar[XB_XCNT(j)]); sum += c; cnt += (c > 0u) ? 1u : 0u; mine = (j == x) ? c : mine; }
        if (sum == G) break;
        __builtin_amdgcn_s_sleep(1);
        if ((++sp & 255u) == 0u) { if (xb_ld(&bar[XB_TMO])) break; if (sp > XB_SPIN_CAP) { atomicAdd(&bar[XB_TMO], 1u); break; } }
    }
    nloc = mine > 0u ? mine : 1u; nx = cnt > 0u ? cnt : 1u;
}
__device__ __forceinline__ void xcd_barrier(const XcdBarrier& b) {
    asm volatile("s_waitcnt vmcnt(0)" ::: "memory");
    __syncthreads();
    if (threadIdx.x == 0) {
        unsigned* bar = b.bar;
        __builtin_amdgcn_s_waitcnt(0);
        unsigned nloc = b.st[0], nx = b.st[1];
        if (nloc == 0u) { xcd_barrier_complete(bar, b.x, nloc, nx); b.st[0] = nloc; b.st[1] = nx; }
        const unsigned old = xb_add(&bar[XB_XSUB(b.x)], 1u);
        const unsigned gen = old / nloc;
        if (old + 1u == (gen + 1u) * nloc) {
            __builtin_amdgcn_fence(__ATOMIC_RELEASE, "agent");
            asm volatile("s_waitcnt vmcnt(0)" ::: "memory");
            const unsigned og = xb_add(&bar[XB_TOP], 1u);
            const unsigned tg = og / nx;
            if (og + 1u == (tg + 1u) * nx) xb_add(&bar[XB_TOPGEN], 1u);
            else XB_SPIN(xb_ld(&bar[XB_TOPGEN]) == tg, bar);
            __builtin_amdgcn_fence(__ATOMIC_ACQUIRE, "agent");
            xb_add(&bar[XB_XGEN(b.x)], 1u);
            asm volatile("s_waitcnt vmcnt(0)" ::: "memory");
        } else {
            XB_SPIN(xb_ld(&bar[XB_XGEN(b.x)]) == gen, bar);
            __builtin_amdgcn_fence(__ATOMIC_ACQUIRE, "agent");
            asm volatile("s_waitcnt vmcnt(0)" ::: "memory");
        }
    }
    __syncthreads();
}

struct Params { const float* in[20]; float* out; unsigned char* ws; };
struct Frame {
    LAS unsigned char* lds;
    int tid, lane, wave, G, bid;
    const float *x_p, *x_s, *cache_k, *cache_v, *cache_ki, *state_pool, *c_p, *c_s, *g_mix, *g_ffn, *w_mod, *b_mod, *w_in, *w_o, *pool_w, *pool_scale, *w_up, *w_down, *g_final;
    const int* page_table;
    float* out; unsigned char* ws;
    float* MOD; bf16_t *SILU, *WIN, *WO, *WPOOL, *WUP, *WDN, *HB, *QB, *KB, *VB, *QIB, *KIB, *OB, *UB; float *WIF, *X; unsigned short* ILG; float *GS, *BIAS, *SSQ, *SLAB; bf16_t* SHB;
};
__device__ __forceinline__ int brow_of(int r) { return r < MP ? (r >> 12) : NBATCH + ((r - MP) >> 2); }

struct NoPre {};
struct EpiProj {
    static constexpr bool PERM = true;
    typedef NoPre Pre;
    __device__ __forceinline__ void prefetch(Pre&, const pg8::Unit&, int, int, int, int) const {}
    bf16_t *QB, *KB, *VB, *QIB, *KIB; float* WIF; float* out;
    __device__ __forceinline__ void operator()(const f32x4 (&acc)[2][2][4][2], const Pre&, const pg8::Unit& u, int wr, int wc, int fr, int fq) const {
        const int pn = u.pn;
#pragma unroll
        for (int ai = 0; ai < 2; ++ai)
#pragma unroll
            for (int m = 0; m < 4; ++m) {
                const int row = u.pm * 256 + ai * 128 + wr * 64 + m * 16 + fr;
#pragma unroll
                for (int bj = 0; bj < 2; ++bj) {
                    const int cl = bj * 128 + wc * 32 + 8 * fq;
                    const f32x4 v0 = acc[ai][bj][m][0], v1 = acc[ai][bj][m][1];
                    const bf16x8 pk = pack8(v0, v1);
                    if (pn < 4) { *(bf16x8*)(QB + (size_t)row * D + pn * 256 + cl) = pk; }
                    else if (pn == 4 || pn == 5) {
                        bf16_t* B = pn == 4 ? KB : VB; *(bf16x8*)(B + (size_t)row * KVW + cl) = pk;
                        float* o = out + (row < MP ? (pn == 4 ? O_KP : O_VP) + (size_t)row * KVW : (pn == 4 ? O_KS : O_VS) + (size_t)(row - MP) * KVW) + cl;
                        *(f32x4*)o = v0; *(f32x4*)(o + 4) = v1;
                    } else if (pn < 8) { *(bf16x8*)(QIB + (size_t)row * QIW + (pn - 6) * 256 + cl) = pk; }
                    else {
                        if (cl < 64) { *(bf16x8*)(KIB + (size_t)(row >> 5) * (32 * IDD) + ((cl >> 3) * 32 + (row & 31)) * 8) = pk;
                            float* o = out + (row < MP ? O_KIP + (size_t)row * IDD : O_KIS + (size_t)(row - MP) * IDD) + cl; *(f32x4*)o = v0; *(f32x4*)(o + 4) = v1; }
                        else if (cl == 64) { float* o = WIF + (size_t)row * 8; *(f32x4*)o = v0; *(f32x4*)(o + 4) = v1; }
                    }
                }
            }
    }
};
struct EpiUp {
    static constexpr bool PERM = true;
    bf16_t* UB; const float* ssq; const float* bias;
    struct Pre { float rs[2][4]; };
    __device__ __forceinline__ void prefetch(Pre& p, const pg8::Unit& u, int wr, int wc, int fr, int fq) const {
        const int row0 = u.pm * 256 + wr * 64 + fr;
#pragma unroll
        for (int ai = 0; ai < 2; ++ai)
#pragma unroll
            for (int m = 0; m < 4; ++m) p.rs[ai][m] = ssq[row0 + ai * 128 + m * 16];
    }
    __device__ __forceinline__ void operator()(const f32x4 (&acc)[2][2][4][2], const Pre& p, const pg8::Unit& u, int wr, int wc, int fr, int fq) const {
        f32x4 bv[2][2];
        const int row0 = u.pm * 256 + wr * 64 + fr, col0 = u.pn * 256 + wc * 32 + 8 * fq;
        const bool uni = u.pm < MP / 256;
        if (uni) { const float* br = bias + (size_t)(row0 >> 12) * DFF + col0;
#pragma unroll
            for (int bj = 0; bj < 2; ++bj) { bv[bj][0] = *(const f32x4*)(br + bj * 128); bv[bj][1] = *(const f32x4*)(br + bj * 128 + 4); } }
#pragma unroll
        for (int ai = 0; ai < 2; ++ai)
#pragma unroll
            for (int m = 0; m < 4; ++m) {
                const int row = row0 + ai * 128 + m * 16;
                const float rs = __builtin_amdgcn_rsqf(p.rs[ai][m] * (1.f / D) + RMS_EPS);
                if (!uni) { const float* br = bias + (size_t)brow_of(row) * DFF + col0;
#pragma unroll
                    for (int bj = 0; bj < 2; ++bj) { bv[bj][0] = *(const f32x4*)(br + bj * 128); bv[bj][1] = *(const f32x4*)(br + bj * 128 + 4); } }
#pragma unroll
                for (int bj = 0; bj < 2; ++bj) {
                    f32x4 v0 = acc[ai][bj][m][0] * rs + bv[bj][0], v1 = acc[ai][bj][m][1] * rs + bv[bj][1];
#pragma unroll
                    for (int j = 0; j < 4; ++j) { const float a = __builtin_amdgcn_fmed3f(v0[j], 0.f, __builtin_inff()), b = __builtin_amdgcn_fmed3f(v1[j], 0.f, __builtin_inff()); v0[j] = a * a; v1[j] = b * b; }
                    *(bf16x8*)(UB + (size_t)row * DFF + col0 + bj * 128) = pack8(v0, v1);
                }
            }
    }
};
struct EpiBias {
    static constexpr bool PERM = false;
    typedef NoPre Pre;
    __device__ __forceinline__ void prefetch(Pre&, const pg8::Unit&, int, int, int, int) const {}
    float* B;
    __device__ __forceinline__ void operator()(const f32x4 (&acc)[2][2][4][2], const Pre&, const pg8::Unit& u, int wr, int wc, int fr, int fq) const {
#pragma unroll
        for (int ai = 0; ai < 2; ++ai)
#pragma unroll
            for (int m = 0; m < 4; ++m) {
                const int row = u.pm * 256 + ai * 128 + wr * 64 + m * 16 + fr;
#pragma unroll
                for (int bj = 0; bj < 2; ++bj)
#pragma unroll
                    for (int n = 0; n < 2; ++n) { const int c = (u.pn & 15) * 256 + bj * 128 + wc * 32 + 16 * n + 4 * fq; *(f32x4*)(B + (size_t)row * DFF + c) = acc[ai][bj][m][n]; }
            }
    }
};
template <int FUSE, bool XFRAG> struct EpiRes {
    static constexpr bool PERM = false;
    const float *xin_p, *xin_s;
    float* X; const float* gate;
    const float* cscale;
    const float* gs; bf16_t* XG; float* ssq; bool xin_frag; float* slab;
    struct Pre { u32x4 xw[XFRAG ? 4 : 1]; f32x4 xr[XFRAG ? 1 : 4]; };
    __device__ __forceinline__ void prefetch(Pre& p, const pg8::Unit& u, int wr, int wc, int fr, int fq) const {
        if (u.atomic || u.pm >= MP / 256) return;
        if (XFRAG) { const bf16_t* xb = (const bf16_t*)xin_p + ((size_t)((u.pm * 4 + u.pn) * 8 + wr * 4 + wc) * 16) * 512 + (size_t)(4 * fr + fq) * 8;
#pragma unroll
            for (int i = 0; i < 4; ++i) p.xw[i] = *(const u32x4*)(xb + (size_t)i * 512); }
        else { const float* xi = xin_p + (size_t)(u.pm * 256 + wr * 64 + fr) * D + u.pn * 256 + wc * 32 + 4 * fq;
#pragma unroll
            for (int bj = 0; bj < 2; ++bj)
#pragma unroll
                for (int n = 0; n < 2; ++n) p.xr[bj * 2 + n] = *(const f32x4*)(xi + bj * 128 + 16 * n); }
    }
    __device__ __forceinline__ void operator()(const f32x4 (&acc)[2][2][4][2], const Pre& p, const pg8::Unit& u, int wr, int wc, int fr, int fq) const {
        const int row0 = u.pm * 256 + wr * 64 + fr, col0 = u.pn * 256 + wc * 32 + 4 * fq;
        if (u.atomic) {
            float* sl = slab + (size_t)(u.k0 / u.nt) * MS * D;
#pragma unroll
            for (int ai = 0; ai < 2; ++ai)
#pragma unroll
                for (int m = 0; m < 4; ++m) { const int row = row0 + ai * 128 + m * 16; const float* gr = gate + (size_t)brow_of(row) * NMOD;
#pragma unroll
                    for (int bj = 0; bj < 2; ++bj)
#pragma unroll
                        for (int n = 0; n < 2; ++n) { const int c = col0 + bj * 128 + 16 * n; f32x4 a = acc[ai][bj][m][n] * *(const f32x4*)(gr + c); if (cscale) a = a * *(const f32x4*)(cscale + c);
                            *(f32x4*)(sl + (size_t)(row - MP) * D + c) = a; } }
            return;
        }
        const bool uni = u.pm < MP / 256;
        if (!uni) {
#pragma unroll 1
            for (int am = 0; am < 8; ++am) { const int ai = am >> 2, m = am & 3; const int row = row0 + ai * 128 + m * 16; const int brow = brow_of(row);
                const float* xi = xin_s + (size_t)(row - MP) * D; float sq = 0.f;
#pragma unroll
                for (int bj = 0; bj < 2; ++bj)
#pragma unroll
                    for (int n = 0; n < 2; ++n) { const int c = col0 + bj * 128 + 16 * n;
                        f32x4 g4 = *(const f32x4*)(gate + (size_t)brow * NMOD + c); if (cscale) g4 = g4 * *(const f32x4*)(cscale + c);
                        f32x4 a4 = (am == 0 ? acc[0][bj][0][n] : am == 1 ? acc[0][bj][1][n] : am == 2 ? acc[0][bj][2][n] : am == 3 ? acc[0][bj][3][n] : am == 4 ? acc[1][bj][0][n] : am == 5 ? acc[1][bj][1][n] : am == 6 ? acc[1][bj][2][n] : acc[1][bj][3][n]);
                        const f32x4 o = *(const f32x4*)(xi + c) + a4 * g4;
                        *(f32x4*)(X + (size_t)row * D + c) = o;
                        if (FUSE != 0) sq += (o[0] * o[0] + o[1] * o[1]) + (o[2] * o[2] + o[3] * o[3]);
                        if (FUSE == 1) { const f32x4 g = o * *(const f32x4*)(gs + (size_t)brow * D + c); u32x2 w2; w2.x = pk2(g[0], g[1]); w2.y = pk2(g[2], g[3]); *(u32x2*)(XG + (size_t)row * D + c) = w2; } }
                if (FUSE != 0) { sq += __shfl_xor(sq, 1); sq += __shfl_xor(sq, 2); if (fq == 0) (void)__hip_atomic_fetch_add(ssq + row, sq, __ATOMIC_RELAXED, __HIP_MEMORY_SCOPE_AGENT); } }
            return;
        }
        const size_t fbase = ((size_t)((u.pm * 4 + u.pn) * 8 + wr * 4 + wc) * 16) * 512 + (size_t)(4 * fr + fq) * 8;
        bf16_t* XB = (bf16_t*)X;
        f32x4 gv[2][2], sv[2][2];
#pragma unroll
        for (int bj = 0; bj < 2; ++bj)
#pragma unroll
            for (int n = 0; n < 2; ++n) { const int c = col0 + bj * 128 + 16 * n; const int br = row0 >> 12;
                gv[bj][n] = *(const f32x4*)(gate + (size_t)br * NMOD + c); if (cscale) gv[bj][n] = gv[bj][n] * *(const f32x4*)(cscale + c);
                if (FUSE == 1) sv[bj][n] = *(const f32x4*)(gs + (size_t)br * D + c); }
#pragma unroll
        for (int g2 = 0; g2 < 4; ++g2) {
            const int ai = g2 >> 1;
            f32x4 xr[2][2][2]; u32x4 xw[2][2];
#pragma unroll
            for (int mm = 0; mm < 2; ++mm) { const int m_ = (g2 & 1) * 2 + mm; const int row = row0 + ai * 128 + m_ * 16;
#pragma unroll
                for (int bj = 0; bj < 2; ++bj) {
                    if (XFRAG) xw[mm][bj] = g2 == 0 ? p.xw[m_ * 2 + bj] : *(const u32x4*)((const bf16_t*)xin_p + fbase + (size_t)(((ai * 4 + m_) * 2 + bj) * 512));
                    else {
#pragma unroll
                        for (int n = 0; n < 2; ++n) xr[mm][bj][n] = (g2 == 0 && mm == 0) ? p.xr[bj * 2 + n] : *(const f32x4*)(xin_p + (size_t)row * D + col0 + bj * 128 + 16 * n); } } }
#pragma unroll
            for (int mm = 0; mm < 2; ++mm) {
                const int m = (g2 & 1) * 2 + mm;
                const int row = row0 + ai * 128 + m * 16;
                float sq = 0.f;
#pragma unroll
                for (int bj = 0; bj < 2; ++bj) {
                    f32x4 o2[2];
#pragma unroll
                    for (int n = 0; n < 2; ++n) {
                        f32x4 xv;
                        if (XFRAG) { const unsigned lo_ = n == 0 ? xw[mm][bj].x : xw[mm][bj].z, hi_ = n == 0 ? xw[mm][bj].y : xw[mm][bj].w; xv = (f32x4){bflo(lo_), bfhi(lo_), bflo(hi_), bfhi(hi_)}; }
                        else xv = xr[mm][bj][n];
                        const f32x4 o = xv + acc[ai][bj][m][n] * gv[bj][n]; o2[n] = o;
                        if (FUSE != 0) sq += (o[0] * o[0] + o[1] * o[1]) + (o[2] * o[2] + o[3] * o[3]);
                        if (FUSE == 1) { const f32x4 g = o * sv[bj][n]; u32x2 w2; w2.x = pk2(g[0], g[1]); w2.y = pk2(g[2], g[3]); *(u32x2*)(XG + (size_t)row * D + col0 + bj * 128 + 16 * n) = w2; }
                    }
                    *(bf16x8*)(XB + fbase + (size_t)(((ai * 4 + m) * 2 + bj) * 512)) = pack8(o2[0], o2[1]);
                }
                if (FUSE != 0) { sq += __shfl_xor(sq, 1); sq += __shfl_xor(sq, 2); if (fq == 0) (void)__hip_atomic_fetch_add(ssq + row, sq, __ATOMIC_RELAXED, __HIP_MEMORY_SCOPE_AGENT); }
            }
        }
    }
};
struct BiasOrder {
    int c;
    __device__ bool next(int i, pg8::Unit& u) const { if (i != 0 || c < 96 || c >= 128) return false; u.pm = (c - 96) >> 4; u.pn = c - 96; u.k0 = 0; u.nt = D / 64; u.atomic = false; return true; }
    __device__ __forceinline__ void a_ready(const pg8::Unit&) const {}
    __device__ __forceinline__ void done(const pg8::Unit&) const {}
};

__device__ __forceinline__ float wave_sum(float v) {
#pragma unroll
    for (int o = 1; o < 64; o <<= 1) v += __shfl_xor(v, o);
    return v;
}
template <int CTRL> __device__ __forceinline__ unsigned dpp_u(unsigned v) { return (unsigned)__builtin_amdgcn_update_dpp(0, (int)v, CTRL, 0xf, 0xf, true); }
__device__ __forceinline__ unsigned wave_sum_u(unsigned v) {
    v += dpp_u<0xB1>(v); v += dpp_u<0x4E>(v); v += dpp_u<0x141>(v); v += dpp_u<0x140>(v);
    return (unsigned)__builtin_amdgcn_readlane((int)v, 0) + (unsigned)__builtin_amdgcn_readlane((int)v, 16) + (unsigned)__builtin_amdgcn_readlane((int)v, 32) + (unsigned)__builtin_amdgcn_readlane((int)v, 48);
}
__device__ __forceinline__ unsigned wave_max_u(unsigned v) {
    unsigned t;
    t = dpp_u<0xB1>(v); v = v > t ? v : t; t = dpp_u<0x4E>(v); v = v > t ? v : t; t = dpp_u<0x141>(v); v = v > t ? v : t; t = dpp_u<0x140>(v); v = v > t ? v : t;
    const unsigned a = (unsigned)__builtin_amdgcn_readlane((int)v, 0), b = (unsigned)__builtin_amdgcn_readlane((int)v, 16), c = (unsigned)__builtin_amdgcn_readlane((int)v, 32), d = (unsigned)__builtin_amdgcn_readlane((int)v, 48);
    const unsigned ab = a > b ? a : b, cd = c > d ? c : d; return ab > cd ? ab : cd;
}

__device__ __forceinline__ void transpose_item(const float* W, int N, bf16_t* WT, int ldo, int row_off, LAS float* scr, int kb, int nb, int lane) {
    const int k0 = 64 * kb, n0 = 32 * nb;
    const int n = n0 + 4 * (lane & 7);
    f32x4 v[8];
#pragma unroll
    for (int i = 0; i < 8; ++i) { const int kk = 8 * i + (lane >> 3); v[i] = (n < N) ? *(const f32x4*)(W + (size_t)(k0 + kk) * N + n) : (f32x4){0.f, 0.f, 0.f, 0.f}; }
#pragma unroll
    for (int i = 0; i < 8; ++i) { const int kk = 8 * i + (lane >> 3); LAS float* d = scr + kk * 33 + 4 * (lane & 7); d[0] = v[i][0]; d[1] = v[i][1]; d[2] = v[i][2]; d[3] = v[i][3]; }
    LDS_WAIT(); asm volatile("" ::: "memory");
    const int c = lane & 7;
#pragma unroll
    for (int j = 0; j < 4; ++j) { const int nn = (lane >> 3) + 8 * j; const LAS float* s = scr + (8 * c) * 33 + nn;
        u32x4 o; o.x = pk2(s[0 * 33], s[1 * 33]); o.y = pk2(s[2 * 33], s[3 * 33]); o.z = pk2(s[4 * 33], s[5 * 33]); o.w = pk2(s[6 * 33], s[7 * 33]);
        *(u32x4*)(WT + (size_t)(row_off + n0 + nn) * ldo + k0 + 8 * c) = o; }
    LDS_WAIT(); asm volatile("" ::: "memory");
}

constexpr int CW_SILU = 8192;
__device__ __forceinline__ void p0_mod_task(Frame& F, int task, unsigned* flag) {
    const int col = F.lane & 15, kq = F.lane >> 4;
    const int l = task / (NMOD / 16), n0 = (task % (NMOD / 16)) * 16;
    const float* W = F.w_mod + (size_t)l * D * NMOD + n0 + col;
    f32x4 acc[9];
#pragma unroll
    for (int i = 0; i < 9; ++i) acc[i] = (f32x4){0.f, 0.f, 0.f, 0.f};
    { unsigned sp = 0; while (__hip_atomic_load(flag, __ATOMIC_RELAXED, __HIP_MEMORY_SCOPE_AGENT) < 144u) { __builtin_amdgcn_s_sleep(4); if (++sp > (1u << 22)) break; }
      __builtin_amdgcn_fence(__ATOMIC_ACQUIRE, "agent"); asm volatile("s_waitcnt vmcnt(0)" ::: "memory"); }
    float f0[8], f1[8]; bf16x8 a0[9], a1[9];
#define MOD_LOAD(f, a, ks) do { const int k0_ = 32 * (ks) + 8 * kq; _Pragma("unroll") for (int j = 0; j < 8; ++j) f[j] = W[(size_t)(k0_ + j) * NMOD]; \
        _Pragma("unroll") for (int mt = 0; mt < 9; ++mt) a[mt] = *(const bf16x8*)(F.SILU + (size_t)(16 * mt + col) * D + k0_); } while (0)
#define MOD_MMA(f, a) do { u32x4 bw; bw.x = pk2(f[0], f[1]); bw.y = pk2(f[2], f[3]); bw.z = pk2(f[4], f[5]); bw.w = pk2(f[6], f[7]); const bf16x8 bfr = __builtin_bit_cast(bf16x8, bw); \
        _Pragma("unroll") for (int mt = 0; mt < 9; ++mt) acc[mt] = __builtin_amdgcn_mfma_f32_16x16x32_bf16(a[mt], bfr, acc[mt], 0, 0, 0); } while (0)
    MOD_LOAD(f0, a0, 0);
    for (int ks = 0; ks < D / 32; ks += 2) {
        MOD_LOAD(f1, a1, ks + 1);
        MOD_MMA(f0, a0);
        if (ks + 2 < D / 32) MOD_LOAD(f0, a0, ks + 2);
        MOD_MMA(f1, a1);
    }
#undef MOD_LOAD
#undef MOD_MMA
    const float bias = F.b_mod[(size_t)l * NMOD + n0 + col];
#pragma unroll
    for (int mt = 0; mt < 9; ++mt)
#pragma unroll
        for (int r = 0; r < 4; ++r) { const int row = 16 * mt + 4 * kq + r; if (row < NBROW) F.MOD[((size_t)l * NBROW + row) * NMOD + n0 + col] = acc[mt][r] + bias; }
}
__device__ __forceinline__ void p0(Frame& F) {
    LAS float* scr = (LAS float*)(F.lds + F.wave * 16384);
    unsigned* flag = (unsigned*)(F.ws + WS_CTL) + CW_SILU;
    const int gw = F.bid * NWAVES + F.wave, NGW = F.G * NWAVES;
    constexpr int I_IN = (D / 64) * (NPROJ / 32), I_O = (D / 64) * (D / 32), I_P = 4 * (256 / 64) * (256 / 32), I_UP = (D / 64) * (DFF / 32), I_DN = (DFF / 64) * (D / 32);
    constexpr int N_SILU = 144, N_MOD = 2 * (NMOD / 16);
    constexpr int NIT = N_SILU + N_MOD + I_IN + I_O + I_P + 2 * I_UP + 2 * I_DN;
    for (int it = gw; it < NIT; it += NGW) {
        int r = it;
        if (r < N_SILU) {
            const float* c = r < NBATCH ? F.c_p + (size_t)r * D : F.c_s + (size_t)(r - NBATCH) * D;
#pragma unroll
            for (int j = 0; j < 4; ++j) {
                f32x4 v = {0.f, 0.f, 0.f, 0.f};
                if (r < NBROW) { v = *(const f32x4*)(c + 4 * F.lane + 256 * j);
#pragma unroll
                    for (int e = 0; e < 4; ++e) v[e] = v[e] * __builtin_amdgcn_rcpf(1.f + __expf(-v[e])); }
                u32x2 o; o.x = pk2(v[0], v[1]); o.y = pk2(v[2], v[3]);
                *(u32x2*)(F.SILU + (size_t)r * D + 4 * F.lane + 256 * j) = o;
            }
            asm volatile("s_waitcnt vmcnt(0)" ::: "memory");
            if (F.lane == 0) { __builtin_amdgcn_fence(__ATOMIC_RELEASE, "agent"); asm volatile("s_waitcnt vmcnt(0)" ::: "memory"); (void)__hip_atomic_fetch_add(flag, 1u, __ATOMIC_RELAXED, __HIP_MEMORY_SCOPE_AGENT); }
            continue;
        } r -= N_SILU;
        if (r < N_MOD) { p0_mod_task(F, r, flag); continue; } r -= N_MOD;
        if (r < I_IN) { transpose_item(F.w_in, DPROJ, F.WIN, D, 0, scr, r / (NPROJ / 32), r % (NPROJ / 32), F.lane); continue; } r -= I_IN;
        if (r < I_O) { transpose_item(F.w_o, D, F.WO, D, 0, scr, r / (D / 32), r % (D / 32), F.lane); continue; } r -= I_O;
        if (r < I_P) { const int g = r / 32, q = r % 32; transpose_item(F.pool_w + (size_t)g * 65536, 256, F.WPOOL, 256, g * 256, scr, q / 8, q % 8, F.lane); continue; } r -= I_P;
        if (r < 2 * I_UP) { const int l = r / I_UP, q = r % I_UP; transpose_item(F.w_up + (size_t)l * D * DFF, DFF, F.WUP + (size_t)l * D * DFF, D, 0, scr, q / (DFF / 32), q % (DFF / 32), F.lane); continue; } r -= 2 * I_UP;
        { const int l = r / I_DN, q = r % I_DN; transpose_item(F.w_down + (size_t)l * D * DFF, D, F.WDN + (size_t)l * D * DFF, DFF, 0, scr, q / (D / 32), q % (D / 32), F.lane); }
    }
}

__device__ __forceinline__ void rowpass_first(Frame& F, const float* mod_l) {
    const int gw = F.bid * NWAVES + F.wave, NGW = F.G * NWAVES;
    for (int r0 = gw * 4; r0 < MT; r0 += NGW * 4) {
        const float* xr = r0 < MP ? F.x_p + (size_t)r0 * D : F.x_s + (size_t)(r0 - MP) * D;
        f32x4 v[4][4];
#pragma unroll
        for (int q = 0; q < 4; ++q)
#pragma unroll
            for (int j = 0; j < 4; ++j) v[q][j] = *(const f32x4*)(xr + (size_t)q * D + 4 * F.lane + 256 * j);
        const float* mr = mod_l + (size_t)brow_of(r0) * NMOD;
        f32x4 gsv[4], shv[4];
#pragma unroll
        for (int j = 0; j < 4; ++j) { const int c = 4 * F.lane + 256 * j; gsv[j] = *(const f32x4*)(F.g_mix + c) * (*(const f32x4*)(mr + D + c) + 1.0f); shv[j] = *(const f32x4*)(mr + c); }
#pragma unroll
        for (int q = 0; q < 4; ++q) {
            float ss = 0.f;
#pragma unroll
            for (int j = 0; j < 4; ++j) ss += (v[q][j].x * v[q][j].x + v[q][j].y * v[q][j].y) + (v[q][j].z * v[q][j].z + v[q][j].w * v[q][j].w);
            const float rstd = __builtin_amdgcn_rsqf(wave_sum(ss) * (1.f / D) + RMS_EPS);
#pragma unroll
            for (int j = 0; j < 4; ++j) { const int c = 4 * F.lane + 256 * j; const f32x4 h = v[q][j] * rstd * gsv[j] + shv[j];
                u32x2 o; o.x = pk2(h[0], h[1]); o.y = pk2(h[2], h[3]); *(u32x2*)(F.HB + (size_t)(r0 + q) * D + c) = o;
                if (r0 >= MP) *(f32x4*)(F.X + (size_t)(r0 + q) * D + c) = v[q][j]; }
        }
    }
    for (int it = gw; it < 3 * NBROW + 2 * 256; it += NGW) {
        if (it < 3 * NBROW) { const int inst = it / NBROW, br = it % NBROW;
            const float* g = inst == 0 ? F.g_ffn : inst == 1 ? F.g_mix + D : F.g_ffn + D;
            const float* sc = F.MOD + ((size_t)(inst == 0 ? 0 : 1) * NBROW + br) * NMOD + (inst == 1 ? 1 : 4) * D;
#pragma unroll
            for (int j = 0; j < 4; ++j) { const int c = 4 * F.lane + 256 * j; *(f32x4*)(F.GS + ((size_t)inst * NBROW + br) * D + c) = *(const f32x4*)(g + c) * (*(const f32x4*)(sc + c) + 1.0f); }
        } else { const int q = it - 3 * NBROW, l = q >> 8, br = q & 255;
#pragma unroll
            for (int j = 0; j < 4; ++j) { const int c = 4 * F.lane + 256 * j; f32x4 v = {0.f, 0.f, 0.f, 0.f}; if (br < NBROW) v = *(const f32x4*)(F.MOD + ((size_t)l * NBROW + br) * NMOD + 3 * D + c);
                u32x2 o; o.x = pk2(v[0], v[1]); o.y = pk2(v[2], v[3]); *(u32x2*)(F.SHB + ((size_t)l * 256 + br) * D + c) = o; }
        }
    }
}
template <int MODE>
__device__ __forceinline__ void rowpass(Frame& F, const float* src_p, const float* src_s, const float* gain, const float* mod_l, int sh_chunk, int sc_chunk, bf16_t* dst) {
    const int gw = F.bid * NWAVES + F.wave, NGW = F.G * NWAVES;
    for (int r = gw; r < MT; r += NGW) {
        const float* xr = r < MP ? src_p + (size_t)r * D : src_s + (size_t)(r - MP) * D;
        f32x4 v[4]; float s = 0.f;
#pragma unroll
        for (int j = 0; j < 4; ++j) { v[j] = *(const f32x4*)(xr + 4 * F.lane + 256 * j); s += (v[j].x * v[j].x + v[j].y * v[j].y) + (v[j].z * v[j].z + v[j].w * v[j].w); }
        const float rstd = (MODE == 2 && r < MP) ? __builtin_amdgcn_rsqf(F.SSQ[3 * MT + r] * (1.f / D) + RMS_EPS) : __builtin_amdgcn_rsqf(wave_sum(s) * (1.f / D) + RMS_EPS);
        if (MODE == 2) {
            float* o = r < MP ? F.out + O_YP + (size_t)r * D : F.out + O_YS + (size_t)(r - MP) * D;
#pragma unroll
            for (int j = 0; j < 4; ++j) { const int c = 4 * F.lane + 256 * j; *(f32x4*)(o + c) = v[j] * rstd * *(const f32x4*)(gain + c); }
        } else {
            const float* mr = mod_l + (size_t)brow_of(r) * NMOD;
            float* po = nullptr;
            if (MODE == 1) {
                if (r < MP) { const int t = r & (SEQ - 1); if (t >= SEQ - POOLST) po = F.out + O_POOLP + ((size_t)(r >> 12) * POOLST + (t - (SEQ - POOLST))) * D; }
                else { const int q = r - MP; po = F.out + O_POOLS + ((size_t)(q >> 2) * POOLST + (POOLST - DECS) + (q & 3)) * D; }
            }
#pragma unroll
            for (int j = 0; j < 4; ++j) { const int c = 4 * F.lane + 256 * j;
                const f32x4 h = v[j] * rstd * *(const f32x4*)(gain + c) * (*(const f32x4*)(mr + sc_chunk * D + c) + 1.0f) + *(const f32x4*)(mr + sh_chunk * D + c);
                u32x2 o; o.x = pk2(h[0], h[1]); o.y = pk2(h[2], h[3]);
                *(u32x2*)(dst + (size_t)r * D + c) = o;
                if (MODE == 3 && r >= MP) *(f32x4*)(F.X + (size_t)r * D + c) = v[j];
                if (MODE == 1 && po) *(f32x4*)(po + c) = h; }
        }
    }
    if (MODE == 3) {
        for (int it = gw; it < 3 * NBROW + 2 * 256; it += NGW) {
            if (it < 3 * NBROW) { const int inst = it / NBROW, br = it % NBROW;
                const float* g = inst == 0 ? F.g_ffn : inst == 1 ? F.g_mix + D : F.g_ffn + D;
                const float* sc = F.MOD + ((size_t)(inst == 0 ? 0 : 1) * NBROW + br) * NMOD + (inst == 1 ? 1 : 4) * D;
#pragma unroll
                for (int j = 0; j < 4; ++j) { const int c = 4 * F.lane + 256 * j; *(f32x4*)(F.GS + ((size_t)inst * NBROW + br) * D + c) = *(const f32x4*)(g + c) * (*(const f32x4*)(sc + c) + 1.0f); }
            } else { const int q = it - 3 * NBROW, l = q >> 8, br = q & 255;
#pragma unroll
                for (int j = 0; j < 4; ++j) { const int c = 4 * F.lane + 256 * j; f32x4 v = {0.f, 0.f, 0.f, 0.f}; if (br < NBROW) v = *(const f32x4*)(F.MOD + ((size_t)l * NBROW + br) * NMOD + 3 * D + c);
                    u32x2 o; o.x = pk2(v[0], v[1]); o.y = pk2(v[2], v[3]); *(u32x2*)(F.SHB + ((size_t)l * 256 + br) * D + c) = o; }
            }
        }
    }
    if (MODE == 1) {
        for (int it = gw; it < DECB * (POOLST - DECS); it += NGW) { const int seq = it / (POOLST - DECS), i = it % (POOLST - DECS);
            const float* s = F.state_pool + ((size_t)seq * POOLST + i + DECS) * D; float* o = F.out + O_POOLS + ((size_t)seq * POOLST + i) * D;
#pragma unroll
            for (int j = 0; j < 4; ++j) *(f32x4*)(o + 4 * F.lane + 256 * j) = *(const f32x4*)(s + 4 * F.lane + 256 * j); }
    }
}

__device__ __forceinline__ void finalpass(Frame& F) {
    const int gw = F.bid * NWAVES + F.wave, NGW = F.G * NWAVES;
    const float* ssq = F.SSQ + 3 * MT;
    const int fr = F.lane >> 2, fq = F.lane & 3;
#pragma unroll 2
    for (int it = gw; it < (MP / 256) * 4 * 8 * 8; it += NGW) {
        const int am = it & 7, wid = (it >> 3) & 7, tile = it >> 6, pm = tile >> 2, pn = tile & 3, wr = wid >> 2, wc = wid & 3;
        const int row = pm * 256 + (am >> 2) * 128 + wr * 64 + (am & 3) * 16 + fr;
        const float rs = __builtin_amdgcn_rsqf(ssq[row] * (1.f / D) + RMS_EPS);
        const bf16_t* xb = (const bf16_t*)F.X + ((size_t)(tile * 8 + wid) * 16 + am * 2) * 512 + F.lane * 8;
        f32x4 v[4];
#pragma unroll
        for (int bj = 0; bj < 2; ++bj) { const u32x4 w4 = *(const u32x4*)(xb + bj * 512);
            v[2 * bj] = (f32x4){bflo(w4.x), bfhi(w4.x), bflo(w4.y), bfhi(w4.y)}; v[2 * bj + 1] = (f32x4){bflo(w4.z), bfhi(w4.z), bflo(w4.w), bfhi(w4.w)}; }
#pragma unroll
        for (int q = 0; q < 4; ++q) { const int c = pn * 256 + (q >> 1) * 128 + wc * 32 + 16 * (q & 1) + 4 * fq;
            *(f32x4*)(F.out + O_YP + (size_t)row * D + c) = v[q] * rs * *(const f32x4*)(F.g_final + c); }
    }
    for (int r = gw; r < MS; r += NGW) {
        const float* xr = F.X + (size_t)(MP + r) * D;
        f32x4 v[4]; float s = 0.f;
#pragma unroll
        for (int j = 0; j < 4; ++j) { const int c = 4 * F.lane + 256 * j; v[j] = *(const f32x4*)(xr + c);
#pragma unroll
            for (int ks = 0; ks < 8; ++ks) v[j] += *(const f32x4*)(F.SLAB + ((size_t)ks * MS + r) * D + c);
            s += (v[j].x * v[j].x + v[j].y * v[j].y) + (v[j].z * v[j].z + v[j].w * v[j].w); }
        const float rstd = __builtin_amdgcn_rsqf(wave_sum(s) * (1.f / D) + RMS_EPS);
#pragma unroll
        for (int j = 0; j < 4; ++j) { const int c = 4 * F.lane + 256 * j; *(f32x4*)(F.out + O_YS + (size_t)r * D + c) = v[j] * rstd * *(const f32x4*)(F.g_final + c); }
    }
}

__device__ __forceinline__ void poolpass(Frame& F, const bf16_t* XG, const float* ssq, const float* mod_l, bf16_t* PB) {
    const bool ded = F.G >= 2 * DECB;
    const bool smp_wave = ded && F.bid < DECB && F.wave == NWAVES - 1;
    const int pw = !ded ? F.bid * NWAVES + F.wave : (F.bid < DECB ? F.bid * (NWAVES - 1) + F.wave : DECB * (NWAVES - 1) + (F.bid - DECB) * NWAVES + F.wave);
    const int gt = pw * 64 + F.lane, NGT = (ded ? F.G * NWAVES - DECB : F.G * NWAVES) * 64;
    if (!smp_wave)
    for (int it = gt; it < (MP / 16) * 128; it += NGT) {
        const int run = it >> 7, c8 = it & 127, g = c8 >> 5, w = 2 << g;
        const int r0 = run * 16, t0 = r0 & (SEQ - 1);
        const bf16_t* xg = XG + 8 * c8;
        float s[8];
#pragma unroll
        for (int e = 0; e < 8; ++e) s[e] = 0.f;
        for (int j = 1; j < w; ++j) { if (t0 - j >= 0) { const u32x4 a = *(const u32x4*)(xg + (size_t)(r0 - j) * D); const float rs = __builtin_amdgcn_rsqf(ssq[r0 - j] * (1.f / D) + RMS_EPS);
            s[0] += bflo(a.x) * rs; s[1] += bfhi(a.x) * rs; s[2] += bflo(a.y) * rs; s[3] += bfhi(a.y) * rs; s[4] += bflo(a.z) * rs; s[5] += bfhi(a.z) * rs; s[6] += bflo(a.w) * rs; s[7] += bfhi(a.w) * rs; } }
        const float* sh = mod_l + (size_t)(r0 >> 12) * NMOD + 8 * c8;
#pragma unroll 4
        for (int i = 0; i < 16; ++i) {
            const int r = r0 + i, t = t0 + i;
            const u32x4 a = *(const u32x4*)(xg + (size_t)r * D); const float rs = __builtin_amdgcn_rsqf(ssq[r] * (1.f / D) + RMS_EPS);
            const float a0[8] = {bflo(a.x) * rs, bfhi(a.x) * rs, bflo(a.y) * rs, bfhi(a.y) * rs, bflo(a.z) * rs, bfhi(a.z) * rs, bflo(a.w) * rs, bfhi(a.w) * rs};
#pragma unroll
            for (int e = 0; e < 8; ++e) s[e] += a0[e];
            const int n = (t + 1) < w ? (t + 1) : w;
            const float ic = __builtin_amdgcn_rcpf((float)n);
            u32x4 o; o.x = pk2(s[0] * ic - a0[0], s[1] * ic - a0[1]); o.y = pk2(s[2] * ic - a0[2], s[3] * ic - a0[3]); o.z = pk2(s[4] * ic - a0[4], s[5] * ic - a0[5]); o.w = pk2(s[6] * ic - a0[6], s[7] * ic - a0[7]);
            *(u32x4*)(PB + (size_t)r * D + 8 * c8) = o;
            if (t >= SEQ - POOLST) {
                float* po = F.out + O_POOLP + ((size_t)(r >> 12) * POOLST + (t - (SEQ - POOLST))) * D + 8 * c8;
                *(f32x4*)po = (f32x4){a0[0], a0[1], a0[2], a0[3]} + *(const f32x4*)sh; *(f32x4*)(po + 4) = (f32x4){a0[4], a0[5], a0[6], a0[7]} + *(const f32x4*)(sh + 4); }
            if (t - w + 1 >= 0) {
                const u32x4 q = *(const u32x4*)(xg + (size_t)(r - w + 1) * D); const float rq = __builtin_amdgcn_rsqf(ssq[r - w + 1] * (1.f / D) + RMS_EPS);
                s[0] -= bflo(q.x) * rq; s[1] -= bfhi(q.x) * rq; s[2] -= bflo(q.y) * rq; s[3] -= bfhi(q.y) * rq; s[4] -= bflo(q.z) * rq; s[5] -= bfhi(q.z) * rq; s[6] -= bflo(q.w) * rq; s[7] -= bfhi(q.w) * rq; }
        }
    }
    const int gw = ded ? (smp_wave ? F.bid : DECB) : F.bid * NWAVES + F.wave, NGW = ded ? DECB : F.G * NWAVES;
    for (int seq = gw; seq < DECB; seq += NGW) {
        const float* mr = mod_l + (size_t)(NBATCH + seq) * NMOD;
        f32x4 h[4][4];
#pragma unroll
        for (int t = 0; t < 4; ++t) { float* xr = F.X + (size_t)(MP + seq * DECS + t) * D; float sq = 0.f;
#pragma unroll
            for (int j = 0; j < 4; ++j) { const int c = 4 * F.lane + 256 * j; f32x4 xv = *(const f32x4*)(xr + c);
#pragma unroll
                for (int ks = 0; ks < 8; ++ks) xv += *(const f32x4*)(F.SLAB + ((size_t)ks * MS + seq * DECS + t) * D + c);
                *(f32x4*)(xr + c) = xv; h[t][j] = xv; sq += (h[t][j].x * h[t][j].x + h[t][j].y * h[t][j].y) + (h[t][j].z * h[t][j].z + h[t][j].w * h[t][j].w); }
            const float rstd = __builtin_amdgcn_rsqf(wave_sum(sq) * (1.f / D) + RMS_EPS);
#pragma unroll
            for (int j = 0; j < 4; ++j) { const int c = 4 * F.lane + 256 * j; h[t][j] = h[t][j] * rstd * *(const f32x4*)(F.g_mix + D + c) * (*(const f32x4*)(mr + D + c) + 1.0f) + *(const f32x4*)(mr + c); } }
#pragma unroll
        for (int j = 0; j < 4; ++j) {
            const int c = 4 * F.lane + 256 * j, w = 2 << j;
            f32x4 ext[19];
#pragma unroll
            for (int i = 0; i < POOLST; ++i) ext[i] = *(const f32x4*)(F.state_pool + ((size_t)seq * POOLST + i) * D + c);
#pragma unroll
            for (int t = 0; t < 4; ++t) ext[POOLST + t] = h[t][j];
            const float iw = 1.0f / (float)w;
#pragma unroll
            for (int t = 0; t < 4; ++t) { f32x4 sm = {0.f, 0.f, 0.f, 0.f};
#pragma unroll
                for (int i = 0; i < 16; ++i) if (i < w) sm += ext[POOLST + t - i];
                const f32x4 p = sm * iw - h[t][j]; u32x2 o; o.x = pk2(p[0], p[1]); o.y = pk2(p[2], p[3]);
                *(u32x2*)(PB + (size_t)(MP + seq * DECS + t) * D + c) = o; }
#pragma unroll
            for (int i = 0; i < POOLST; ++i) *(f32x4*)(F.out + O_POOLS + ((size_t)seq * POOLST + i) * D + c) = ext[i + DECS];
        }
    }
}

__device__ __forceinline__ unsigned okey(float f) { const unsigned u = __float_as_uint(f); return (u & 0x80000000u) ? ~u : (u | 0x80000000u); }
__device__ __forceinline__ bf16x8 ld8_bf(const bf16_t* p) { return *(const bf16x8*)p; }
__device__ __forceinline__ bf16x8 ld8_f32(const float* p) { const f32x4 a = *(const f32x4*)p, b = *(const f32x4*)(p + 4); return pack8(a, b); }
__device__ __forceinline__ s16x4 vtr(const LAS unsigned char* p) { typedef short v4i16_t __attribute__((ext_vector_type(4))); return __builtin_bit_cast(s16x4, __builtin_amdgcn_ds_read_tr16_b64_v4i16((LAS v4i16_t*)p)); }

template <bool F32SRC>
__device__ __forceinline__ void attn_query(Frame& F, int lane, const LAS unsigned short* IL, LAS unsigned char* vst, int nsel, int qrow, int b, const int* pt, int seq, int gsel) {
    constexpr int NB = F32SRC ? 2 : 4;
    asm volatile("" : "+v"(lane));
    const int col = lane & 15, kq = lane >> 4;
    bf16x8 Bq[4];
#pragma unroll
    for (int c = 0; c < 4; ++c) { bf16x8 qv = (bf16x8){0, 0, 0, 0, 0, 0, 0, 0}; if (col < 4) qv = ld8_bf(F.QB + (size_t)qrow * D + (gsel * 4 + col) * HD + 32 * c + 8 * kq); Bq[c] = qv; }
    const int lrow = lane >> 2, lpc = lane & 3;
    const int psrc = (4 * col + kq) * 4;
    const char* kbase = (const char*)(F.KB + (size_t)b * SEQ * KVW + gsel * HD) + lpc * 16;
    unsigned koff[16]; const float* kptr[16];
#pragma unroll
    for (int t = 0; t < 16; ++t) {
        if (F32SRC) { const int key = IL[16 * t + col]; kptr[t] = (key < PAST ? F.cache_k + ((size_t)pt[key >> 7] * PAGE + (key & (PAGE - 1))) * KVW : F.out + O_KS + (size_t)(seq * DECS + key - PAST) * KVW) + gsel * HD + 8 * kq; }
        else { const int key = IL[16 * t + lrow]; koff[t] = (unsigned)key * (KVW * 2); } }
    bf16x8 kbuf[NB][4];
#define ATT_LOADU(u) do { _Pragma("unroll") for (int c_ = 0; c_ < 4; ++c_) \
        kbuf[(u) % NB][c_] = F32SRC ? ld8_f32(kptr[u] + 32 * c_) : ld8_bf((const bf16_t*)(kbase + koff[u] + c_ * 64)); } while (0)
#pragma unroll
    for (int u = 0; u < NB; ++u) ATT_LOADU(u);
    f32x4 S[16];
#pragma unroll
    for (int u = 0; u < 16; ++u) {
        f32x4 a = (f32x4){0.f, 0.f, 0.f, 0.f};
#pragma unroll
        for (int c = 0; c < 4; ++c) {
            bf16x8 kf = kbuf[u % NB][c];
            if (!F32SRC) { u32x4 w = __builtin_bit_cast(u32x4, kf);
                w.x = (unsigned)__builtin_amdgcn_ds_bpermute(psrc, (int)w.x); w.y = (unsigned)__builtin_amdgcn_ds_bpermute(psrc, (int)w.y);
                w.z = (unsigned)__builtin_amdgcn_ds_bpermute(psrc, (int)w.z); w.w = (unsigned)__builtin_amdgcn_ds_bpermute(psrc, (int)w.w);
                kf = __builtin_bit_cast(bf16x8, w); }
            a = __builtin_amdgcn_mfma_f32_16x16x32_bf16(kf, Bq[c], a, 0, 0, 0);
        }
        S[u] = a;
        if (u + NB < 16) ATT_LOADU(u + NB);
    }
#undef ATT_LOADU
    u32x4 R[2][4];
    const char* vbase = (const char*)(F.VB + (size_t)b * SEQ * KVW + gsel * HD) + (lane & 15) * 16;
#define ATT_LOADV(hb, blk) do { _Pragma("unroll") for (int ld_ = 0; ld_ < 4; ++ld_) { const int key_ = IL[32 * (blk) + 16 * (hb) + 4 * ld_ + (lane >> 4)]; \
        if (F32SRC) R[hb][ld_] = __builtin_bit_cast(u32x4, ld8_f32((key_ < PAST ? F.cache_v + ((size_t)pt[key_ >> 7] * PAGE + (key_ & (PAGE - 1))) * KVW : F.out + O_VS + (size_t)(seq * DECS + key_ - PAST) * KVW) + gsel * HD + 8 * (lane & 15))); \
        else R[hb][ld_] = *(const u32x4*)(vbase + (unsigned)key_ * (KVW * 2)); } } while (0)
    ATT_LOADV(0, 0); ATT_LOADV(1, 0);
    float mxs = -INFINITY;
    if (nsel < TOPK) {
#pragma unroll
        for (int t = 0; t < 16; ++t)
#pragma unroll
            for (int r = 0; r < 4; ++r) { const int p = 16 * t + 4 * kq + r; if (p >= nsel) S[t][r] = -INFINITY; }
    }
#pragma unroll
    for (int t = 0; t < 16; ++t) mxs = fmaxf(fmaxf(mxs, fmaxf(S[t][0], S[t][1])), fmaxf(S[t][2], S[t][3]));
    mxs = fmaxf(mxs, __shfl_xor(mxs, 16)); mxs = fmaxf(mxs, __shfl_xor(mxs, 32));
    const float c2 = 0.08838834764831845f * 1.4426950408889634f;
    float lsum = 0.f;
#pragma unroll
    for (int t = 0; t < 16; ++t)
#pragma unroll
        for (int r = 0; r < 4; ++r) { const float p = __builtin_amdgcn_exp2f((S[t][r] - mxs) * c2); S[t][r] = p; lsum += p; }
    lsum += __shfl_xor(lsum, 16); lsum += __shfl_xor(lsum, 32);
    bf16x8 PA[8];
#pragma unroll
    for (int i = 0; i < 8; ++i) PA[i] = pack8(S[2 * i], S[2 * i + 1]);
    f32x4 O[8];
#pragma unroll
    for (int dt = 0; dt < 8; ++dt) O[dt] = (f32x4){0.f, 0.f, 0.f, 0.f};
    const int q_ = (lane & 15) >> 2, p_ = lane & 3;
    const int s0 = 4 * kq + q_;
#pragma unroll
    for (int i = 0; i < 8; ++i) {
#pragma unroll
        for (int hb = 0; hb < 2; ++hb) {
#pragma unroll
            for (int ld = 0; ld < 4; ++ld) { const int slot = 16 * hb + 4 * ld + (lane >> 4), ch = lane & 15;
                *(LAS u32x4*)(vst + slot * 256 + ((ch ^ ((slot & 7) << 1)) << 4)) = R[hb][ld]; }
            if (i + 1 < 8) { if (hb == 0) ATT_LOADV(0, i + 1); else ATT_LOADV(1, i + 1); }
        }
        asm volatile("" ::: "memory");
#pragma unroll
        for (int dt = 0; dt < 8; ++dt) {
            const int ch = dt * 2 + (p_ >> 1);
            const LAS unsigned char* a0 = vst + s0 * 256 + ((ch ^ ((s0 & 7) << 1)) << 4) + (p_ & 1) * 8;
            const s16x4 lo = vtr(a0), hi = vtr(a0 + 16 * 256);
            const bf16x8 bv = (bf16x8){lo[0], lo[1], lo[2], lo[3], hi[0], hi[1], hi[2], hi[3]};
            O[dt] = __builtin_amdgcn_mfma_f32_16x16x32_bf16(PA[i], bv, O[dt], 0, 0, 0);
        }
        asm volatile("" ::: "memory");
    }
#undef ATT_LOADV
    float inv[4];
#pragma unroll
    for (int h = 0; h < 4; ++h) inv[h] = __builtin_amdgcn_rcpf(__shfl(lsum, h));
    if (kq == 0) {
        bf16_t* ob = F.OB + (size_t)qrow * D + gsel * 4 * HD;
#pragma unroll
        for (int dt = 0; dt < 8; ++dt)
#pragma unroll
            for (int r = 0; r < 4; ++r) ob[r * HD + 16 * dt + col] = (bf16_t)(pk2(O[dt][r] * inv[r], 0.f) & 0xffffu);
    }
}

template <bool SAMPLE>
__device__ __forceinline__ void dsa_item(Frame& F, int item) {
    constexpr int NQ = SAMPLE ? 4 : 8, NG = SAMPLE ? 1 : 2, NREG = SAMPLE ? 33 : 64;
    int lane = F.lane; asm volatile("" : "+v"(lane));
    const int w = F.wave;
    LAS float* SC = (LAS float*)F.lds;
    LAS unsigned short* IDXL = (LAS unsigned short*)(F.lds + IDXL_OFF);
    const int seq = item;
    const int b = SAMPLE ? seq : (item & 3), t0 = SAMPLE ? PAST : (item >> 2) * 8;
    const int row0 = SAMPLE ? MP + seq * DECS : b * SEQ + t0;
    const int* pt = F.page_table + (SAMPLE ? seq * PAGES_PER_SEQ : 0);
    {
        const int r = lane & 31, hk = lane >> 5, hi = hk;
        const int q4 = (r >> 4) + 2 * ((r >> 2) & 1), head = (r & 3) + 4 * ((r >> 3) & 1);
        bf16x8 afr[NG][4]; float wiA[NG][8], wiB[NG][8];
        const float cs = 0.125f * 0.35355339059327373f;
#pragma unroll
        for (int G = 0; G < NG; ++G) {
#pragma unroll
            for (int c = 0; c < 4; ++c) afr[G][c] = ld8_bf(F.QIB + (size_t)(row0 + 4 * G + q4) * QIW + head * IDD + 16 * c + 8 * hk);
            const float* wa = F.WIF + (size_t)(row0 + 4 * G + 2 * hi) * 8;
#pragma unroll
            for (int h = 0; h < 8; ++h) { wiA[G][h] = wa[h] * cs; wiB[G][h] = wa[8 + h] * cs; }
        }
        const int nkt = SAMPLE ? 65 : (t0 + 8 + 31) / 32;
        auto load_tile = [&](bf16x8 (&fr)[4], int kt) {
            if (SAMPLE) {
                const int s_ = 32 * kt + r, sc = s_ < PAST + DECS - 1 ? s_ : PAST + DECS - 1;
                const int page = pt[kt < PAST / 32 ? (kt >> 2) : 0];
                const float* kp = kt < PAST / 32 ? F.cache_ki + ((size_t)page * PAGE + (sc & (PAGE - 1))) * IDD : F.out + O_KIS + (size_t)(seq * DECS + sc - PAST) * IDD;
#pragma unroll
                for (int c = 0; c < 4; ++c) fr[c] = ld8_f32(kp + 16 * c + 8 * hk);
            } else {
                const bf16_t* kp = F.KIB + ((size_t)(b * SEQ) / 32 + kt) * (32 * IDD) + (hk * 32 + r) * 8;
#pragma unroll
                for (int c = 0; c < 4; ++c) fr[c] = ld8_bf(kp + c * (2 * 32 * 8));
            }
        };
        auto do_tile = [&](const bf16x8 (&fr)[4], int kt) {
            const int s_ = 32 * kt + r;
#pragma unroll
            for (int G = 0; G < NG; ++G) {
                f32x16 acc;
#pragma unroll
                for (int i = 0; i < 16; ++i) acc[i] = 0.f;
#pragma unroll
                for (int c = 0; c < 4; ++c) acc = __builtin_amdgcn_mfma_f32_32x32x16_bf16(afr[G][c], fr[c], acc, 0, 0, 0);
                float sA = 0.f, sB = 0.f;
#pragma unroll
                for (int h = 0; h < 8; ++h) { sA += __builtin_amdgcn_fmed3f(acc[h], 0.f, __builtin_inff()) * wiA[G][h]; sB += __builtin_amdgcn_fmed3f(acc[8 + h], 0.f, __builtin_inff()) * wiB[G][h]; }
                SC[(4 * G + 2 * hi) * 4096 + s_] = sA + 0.0f; SC[(4 * G + 2 * hi + 1) * 4096 + s_] = sB + 0.0f;
            }
        };
        bf16x8 f0[4], f1[4];
        int kt = w;
        if (kt < nkt) load_tile(f0, kt);
        for (; kt < nkt; kt += 2 * NWAVES) {
            if (kt + NWAVES < nkt) load_tile(f1, kt + NWAVES);
            do_tile(f0, kt);
            if (kt + NWAVES < nkt) { if (kt + 2 * NWAVES < nkt) load_tile(f0, kt + 2 * NWAVES); do_tile(f1, kt + NWAVES); }
        }
    }
    __syncthreads();
    if (w < NQ) {
        asm volatile("" : "+v"(lane));
        const int qi = w;
        const int pos = t0 + qi, nvalid = pos + 1;
        const int nsel = nvalid < TOPK ? nvalid : TOPK;
        LAS unsigned short* IL = IDXL + w * 256;
        if (nvalid <= TOPK) {
#pragma unroll
            for (int i = 0; i < 4; ++i) { const int p = lane + 64 * i; IL[p] = (unsigned short)(p < nvalid ? p : 0); }
        } else {
            const LAS float* scl = SC + qi * 4096 + lane; asm volatile("" : "+v"(scl));
            constexpr int NCH = (NREG + 7) / 8;
            const int nch = (nvalid + 511) >> 9;
            unsigned u[NCH * 8]; unsigned mx = 0u;
#pragma unroll
            for (int c = 0; c < NCH; ++c) {
#pragma unroll
                for (int j = 0; j < 8; ++j) u[8 * c + j] = 0u;
                if (c < nch) {
#pragma unroll
                    for (int j = 0; j < 8; ++j) { const int s = 64 * (8 * c + j) + lane; const unsigned k = okey(scl[64 * (8 * c + j)]); u[8 * c + j] = s < nvalid ? k : 0u; mx = mx > u[8 * c + j] ? mx : u[8 * c + j]; }
                }
            }
            mx = wave_max_u(mx);
            LAS unsigned* hist = (LAS unsigned*)(F.lds + HIST_OFF) + w * 256;
            unsigned lo, wl, above = 0u, T, ngt;
            if (mx >= 0x80000000u + (1u << 25)) { lo = mx + 1u - (1u << 25); wl = 25u; } else { lo = 0u; wl = 32u; }
            for (;;) {
                const unsigned shift = wl > 8u ? wl - 8u : 0u;
                *(LAS u32x4*)(hist + 4 * lane) = (u32x4){0u, 0u, 0u, 0u};
#pragma unroll
                for (int c = 0; c < NCH; ++c) {
                    if (c < nch) {
#pragma unroll
                        for (int j = 0; j < 8; ++j) { const unsigned d = u[8 * c + j] - lo; const bool in = wl >= 32u ? true : (d >> wl) == 0u;
                            if (in) (void)__hip_atomic_fetch_add(hist + (d >> shift), 1u, __ATOMIC_RELAXED, __HIP_MEMORY_SCOPE_WORKGROUP); }
                    }
                }
                LDS_WAIT(); asm volatile("" ::: "memory");
                const u32x4 h4 = *(const LAS u32x4*)(hist + 4 * lane);
                const unsigned sl = (h4.x + h4.y) + (h4.z + h4.w);
                unsigned pre = sl;
#pragma unroll
                for (int o = 1; o < 64; o <<= 1) { const unsigned t = (unsigned)__shfl_up((int)pre, o); if (lane >= o) pre += t; }
                const unsigned total = (unsigned)__builtin_amdgcn_readlane((int)pre, 63);
                if (above + total < (unsigned)TOPK) { lo = 0u; wl = 32u; above = 0u; continue; }
                const unsigned suf = total - pre + sl;
                const unsigned long long bm = __ballot(above + suf >= (unsigned)TOPK);
                const int L = 63 - __builtin_clzll(bm);
                unsigned acc = above + suf - sl, bsel = 0u, csel = 0u, asel = 0u; bool fnd = false;
#pragma unroll
                for (int q = 3; q >= 0; --q) { const unsigned h = h4[q]; if (!fnd && acc + h >= (unsigned)TOPK) { bsel = 4u * (unsigned)lane + (unsigned)q; csel = h; asel = acc; fnd = true; } acc += h; }
                const unsigned bstar = (unsigned)__builtin_amdgcn_readlane((int)bsel, L), cnt_b = (unsigned)__builtin_amdgcn_readlane((int)csel, L);
                above = (unsigned)__builtin_amdgcn_readlane((int)asel, L);
                lo += bstar << shift;
                if (above + cnt_b == (unsigned)TOPK) { T = lo - 1u; ngt = (unsigned)TOPK; break; }
                if (shift == 0u) { T = lo; ngt = above; break; }
                wl = shift;
            }
            const unsigned need_eq = (unsigned)TOPK - ngt;
            unsigned base = 0u, eqb = 0u;
#pragma unroll
            for (int c = 0; c < NCH; ++c) {
                if (c < nch) {
#pragma unroll
                    for (int j = 0; j < 8; ++j) {
                        const int i = 8 * c + j;
                        const bool gt = u[i] > T, eq = u[i] == T;
                        const unsigned long long be = __ballot(eq);
                        const unsigned er = eqb + __builtin_amdgcn_mbcnt_hi((unsigned)(be >> 32), __builtin_amdgcn_mbcnt_lo((unsigned)be, 0u));
                        const bool sel = gt || (eq && er < need_eq);
                        const unsigned long long bs = __ballot(sel);
                        const unsigned p = base + __builtin_amdgcn_mbcnt_hi((unsigned)(bs >> 32), __builtin_amdgcn_mbcnt_lo((unsigned)bs, 0u));
                        if (sel && p < (unsigned)TOPK) IL[p] = (unsigned short)(64 * i + lane);
                        base += (unsigned)__popcll(bs); eqb += (unsigned)__popcll(be);
                    }
                }
            }
        }
        LDS_WAIT(); asm volatile("" ::: "memory");
        *(u32x2*)(F.ILG + (size_t)(row0 + qi) * TOPK + 4 * lane) = *(const LAS u32x2*)(IL + 4 * lane);
    }
    __syncthreads();
}
__device__ __forceinline__ void dsa_select_phase(Frame& F) {
    for (int k = F.bid; k < MP / 8; k += F.G) { const int kk = ((k >> 8) & 1) ? (k ^ 255) : k; dsa_item<false>(F, kk); }
    for (int s = F.bid; s < DECB; s += F.G) dsa_item<true>(F, s);
}
__device__ __forceinline__ void dsa_attn_phase(Frame& F, unsigned* bar, volatile LAS unsigned* st) {
    int lane = F.lane; asm volatile("" : "+v"(lane));
    const int w = F.wave;
    LAS unsigned short* IL = (LAS unsigned short*)(F.lds + IDXL_OFF) + w * 256;
    LAS unsigned char* vst = F.lds + w * 8192;
    if (F.tid == 0) {
        unsigned ok = 1u, nx = 0u, vx = 0u; const unsigned x = st[3];
        for (unsigned j = 0; j < 16; ++j) { const unsigned c = xb_ld(&bar[XB_XCNT(j)]); if (c) { if (c != 32u) ok = 0u; if (j < x) ++vx; ++nx; } }
        if (nx != 8u || F.G != 256) ok = 0u;
        st[4] = ok; st[5] = vx;
    }
    __syncthreads();
    const bool xok = st[4] != 0u;
    const int vx = xok ? (int)st[5] : (F.bid & 7), rk = xok ? (int)st[2] : (F.bid >> 3);
    if (F.G == 256) {
        const int b = vx >> 1, g = vx & 1, wv = rk * 8 + w;
        const int ntask = w < 4 ? 15 : 17;
        for (int i = 0; i < ntask; ++i) {
            const int t = i < 15 ? wv + 256 * i : (i == 15 ? 3840 + rk * 8 + 2 * (w - 4) : 3840 + rk * 8 + 2 * (w - 4) + 1), qrow = b * SEQ + t;
            *(LAS u32x2*)(IL + 4 * lane) = *(const u32x2*)(F.ILG + (size_t)qrow * TOPK + 4 * lane);
            attn_query<false>(F, lane, IL, vst, t + 1 < TOPK ? t + 1 : TOPK, qrow, b, nullptr, 0, g);
        }
    } else {
        for (int task = F.bid * NWAVES + w; task < MP * 2; task += F.G * NWAVES) {
            const int qrow = task >> 1, g = task & 1, b = qrow >> 12, t = qrow & (SEQ - 1);
            *(LAS u32x2*)(IL + 4 * lane) = *(const u32x2*)(F.ILG + (size_t)qrow * TOPK + 4 * lane);
            attn_query<false>(F, lane, IL, vst, t + 1 < TOPK ? t + 1 : TOPK, qrow, b, nullptr, 0, g);
        }
    }
    if (w < 4) {
        for (int task = F.bid * 4 + w; task < MS * 2; task += F.G * 4) {
            const int q = task >> 1, g = task & 1, seq = q >> 2, qrow = MP + q;
            *(LAS u32x2*)(IL + 4 * lane) = *(const u32x2*)(F.ILG + (size_t)qrow * TOPK + 4 * lane);
            attn_query<true>(F, lane, IL, vst, TOPK, qrow, 0, F.page_table + seq * PAGES_PER_SEQ, seq, g);
        }
    }
}

__global__ void __launch_bounds__(NTHREADS, 2) fwd_megakernel(Params P) {
    extern __shared__ __attribute__((aligned(16))) unsigned char lds_raw[];
    Frame F;
#define BUILD_FRAME() do { \
    int tid_ = threadIdx.x; asm volatile("" : "+v"(tid_)); \
    unsigned char* ws_ = as_global(P.ws); float* out_ = as_global(P.out); \
    F.lds = (LAS unsigned char*)lds_raw; \
    F.tid = tid_; F.lane = F.tid & 63; F.wave = __builtin_amdgcn_readfirstlane(F.tid >> 6); F.G = gridDim.x; F.bid = blockIdx.x; \
    F.x_p = as_global(P.in[0]); F.x_s = as_global(P.in[1]); F.cache_k = as_global(P.in[2]); F.cache_v = as_global(P.in[3]); F.cache_ki = as_global(P.in[4]); F.state_pool = as_global(P.in[5]); F.page_table = as_global((const int*)P.in[6]); \
    F.c_p = as_global(P.in[7]); F.c_s = as_global(P.in[8]); F.g_mix = as_global(P.in[9]); F.g_ffn = as_global(P.in[10]); F.w_mod = as_global(P.in[11]); F.b_mod = as_global(P.in[12]); F.w_in = as_global(P.in[13]); F.w_o = as_global(P.in[14]); \
    F.pool_w = as_global(P.in[15]); F.pool_scale = as_global(P.in[16]); F.w_up = as_global(P.in[17]); F.w_down = as_global(P.in[18]); F.g_final = as_global(P.in[19]); \
    F.out = out_; F.ws = ws_; \
    F.MOD = (float*)(ws_ + WS_MOD); F.SILU = (bf16_t*)(ws_ + WS_SILU); F.WIN = (bf16_t*)(ws_ + WS_WIN); F.WO = (bf16_t*)(ws_ + WS_WO); F.WPOOL = (bf16_t*)(ws_ + WS_WPOOL); \
    F.WUP = (bf16_t*)(ws_ + WS_WUP); F.WDN = (bf16_t*)(ws_ + WS_WDN); F.HB = (bf16_t*)(ws_ + WS_HB); F.QB = (bf16_t*)(ws_ + WS_QB); F.KB = (bf16_t*)(ws_ + WS_KB); F.VB = (bf16_t*)(ws_ + WS_VB); \
    F.QIB = (bf16_t*)(ws_ + WS_QIB); F.KIB = (bf16_t*)(ws_ + WS_KIB); F.WIF = (float*)(ws_ + WS_WIF); F.OB = (bf16_t*)(ws_ + WS_OB); F.X = (float*)(ws_ + WS_X); F.UB = (bf16_t*)(ws_ + WS_UB); F.ILG = (unsigned short*)(ws_ + WS_IL); F.GS = (float*)(ws_ + WS_GS); F.BIAS = (float*)(ws_ + WS_BIAS); F.SHB = (bf16_t*)(ws_ + WS_SHB); F.SLAB = (float*)(ws_ + WS_SLAB); F.SSQ = (float*)(ws_ + WS_CTL) + CW_SSQ; \
    mod0 = F.MOD; mod1 = F.MOD + (size_t)NBROW * NMOD; } while (0)
    const float* mod0; const float* mod1;
    unsigned char* ws = P.ws;
    volatile LAS unsigned* MISC = (volatile LAS unsigned*)((LAS unsigned char*)lds_raw + MISC_OFF);
    for (int u = threadIdx.x; u < 64; u += NTHREADS) MISC[u] = 0u;
    __syncthreads();
    XcdBarrier bar = xcd_barrier_post((unsigned*)(ws + WS_CTL) + CW_BAR, MISC + 8);
#define GRID_BAR() do { xcd_barrier(bar); BUILD_FRAME(); } while (0)

    BUILD_FRAME();
    p0(F);
    cg::this_grid().sync();
    BUILD_FRAME();
    rowpass_first(F, mod0);
    GRID_BAR();
    {   pg8::Gemm g{F.HB, F.WIN, MT, NPROJ, D, D, D, 0}; pg8::MixOrder S; S.init(MP, MS, NPROJ, D, 1, F.G, F.bid);
        EpiProj E{F.QB, F.KB, F.VB, F.QIB, F.KIB, F.WIF, F.out};
        pg8::gemm_phase<EpiProj, pg8::MixOrder, true>(F.lds, g, S, E); }
    {   pg8::Gemm g{F.SHB, F.WUP, 512, 2 * DFF, D, D, D, 0}; BiasOrder S{F.bid};
        EpiBias E{F.BIAS};
        pg8::gemm_phase<EpiBias, BiasOrder, true>(F.lds, g, S, E); }
    GRID_BAR();
    dsa_select_phase(F);
    GRID_BAR();
    dsa_attn_phase(F, (unsigned*)(ws + WS_CTL) + CW_BAR, MISC + 8);
    GRID_BAR();
    {   pg8::Gemm g{F.OB, F.WO, MT, D, D, D, D, 0}; pg8::MixOrder S; S.init(MP, MS, D, D, 1, F.G, F.bid);
        EpiRes<1, false> E{F.x_p, F.x_s, F.X, mod0 + 2 * D, nullptr, F.GS, F.HB, F.SSQ, false, nullptr};
        pg8::gemm_phase<EpiRes<1, false>, pg8::MixOrder, true>(F.lds, g, S, E); }
    GRID_BAR();
    {   pg8::Gemm g{F.HB, F.WUP, MT, DFF, D, D, D, 0}; pg8::MixOrder S; S.init(MP, MS, DFF, D, 1, F.G, F.bid);
        EpiUp E{F.UB, F.SSQ, F.BIAS};
        pg8::gemm_phase<EpiUp, pg8::MixOrder, true>(F.lds, g, S, E); }
    GRID_BAR();
    {   pg8::Gemm g{F.UB, F.WDN, MT, D, DFF, DFF, DFF, 0}; pg8::MixOrder S; S.init(MP, MS, D, DFF, 8, F.G, F.bid);
        EpiRes<1, true> E{F.X, F.X + (size_t)MP * D, F.X, mod0 + 5 * D, nullptr, F.GS + (size_t)NBROW * D, F.HB, F.SSQ + MT, true, F.SLAB};
        pg8::gemm_phase<EpiRes<1, true>, pg8::MixOrder, true>(F.lds, g, S, E); }
    GRID_BAR();
    poolpass(F, F.HB, F.SSQ + MT, mod1, F.OB);
    GRID_BAR();
    {   pg8::Gemm g{F.OB, F.WPOOL, MT, D, 256, D, 256, 256}; pg8::MixOrder S; S.init(MP, MS, D, 256, 1, F.G, F.bid);
        EpiRes<1, true> E{F.X, F.X + (size_t)MP * D, F.X, mod1 + 2 * D, F.pool_scale, F.GS + (size_t)2 * NBROW * D, F.HB, F.SSQ + 2 * MT, true, nullptr};
        pg8::gemm_phase<EpiRes<1, true>, pg8::MixOrder, true>(F.lds, g, S, E); }
    GRID_BAR();
    {   pg8::Gemm g{F.HB, F.WUP + (size_t)D * DFF, MT, DFF, D, D, D, 0}; pg8::MixOrder S; S.init(MP, MS, DFF, D, 1, F.G, F.bid);
        EpiUp E{F.UB, F.SSQ + 2 * MT, F.BIAS + (size_t)256 * DFF};
        pg8::gemm_phase<EpiUp, pg8::MixOrder, true>(F.lds, g, S, E); }
    GRID_BAR();
    {   pg8::Gemm g{F.UB, F.WDN + (size_t)D * DFF, MT, D, DFF, DFF, DFF, 0}; pg8::MixOrder S; S.init(MP, MS, D, DFF, 8, F.G, F.bid);
        EpiRes<2, true> E{F.X, F.X + (size_t)MP * D, F.X, mod1 + 5 * D, nullptr, nullptr, nullptr, F.SSQ + 3 * MT, true, F.SLAB};
        pg8::gemm_phase<EpiRes<2, true>, pg8::MixOrder, true>(F.lds, g, S, E); }
    GRID_BAR();
    finalpass(F);
}

extern "C" void kernel_launch(void* const* d_in, const int* in_sizes, int n_in, void* d_out, int out_size, void* d_ws, size_t ws_size, hipStream_t stream) {
    static int grid = 0;
    if (grid == 0) {
        if (n_in != 20 || (size_t)out_size != O_END || ws_size < WS_END) { fprintf(stderr, "kernel_launch: unexpected shapes (n_in %d out %d ws %zu)\n", n_in, out_size, ws_size); grid = -1; return; }
        int dev = 0, cus = 0, per_cu = 0;
        if (hipGetDevice(&dev) != hipSuccess || hipDeviceGetAttribute(&cus, hipDeviceAttributeMultiprocessorCount, dev) != hipSuccess) { grid = -1; return; }
        if (hipFuncSetAttribute((const void*)fwd_megakernel, hipFuncAttributeMaxDynamicSharedMemorySize, LDS_BYTES) != hipSuccess) { fprintf(stderr, "kernel_launch: hipFuncSetAttribute failed\n"); grid = -1; return; }
        if (hipOccupancyMaxActiveBlocksPerMultiprocessor(&per_cu, (const void*)fwd_megakernel, NTHREADS, LDS_BYTES) != hipSuccess || per_cu < 1) { fprintf(stderr, "kernel_launch: occupancy query failed (%d)\n", per_cu); (void)hipGetLastError(); grid = -1; return; }
        grid = cus;
    }
    if (grid < 0) return;
    (void)hipMemsetAsync((char*)d_ws + WS_CTL, 0, CTL_ZERO_BYTES, stream);
    Params p{};
    for (int i = 0; i < 20; ++i) p.in[i] = (const float*)d_in[i];
    p.out = (float*)d_out; p.ws = (unsigned char*)d_ws;
    void* args[] = {&p};
    hipError_t e = hipLaunchCooperativeKernel((const void*)fwd_megakernel, dim3(grid), dim3(NTHREADS), args, LDS_BYTES, stream);
    if (e != hipSuccess) fprintf(stderr, "cooperative launch failed: %s (grid %d)\n", hipGetErrorString(e), grid);
}
```

```cpp
#include <hip/hip_runtime.h>
#include <hip/hip_cooperative_groups.h>
#include <cstdio>
#include <cstdint>
namespace cg = cooperative_groups;

#define LAS __attribute__((address_space(3)))
typedef unsigned short bf16_t;
typedef short bf16x8 __attribute__((ext_vector_type(8)));
typedef short s16x4 __attribute__((ext_vector_type(4)));
typedef float f32x2 __attribute__((ext_vector_type(2)));
typedef float f32x4 __attribute__((ext_vector_type(4)));
typedef float f32x16 __attribute__((ext_vector_type(16)));
typedef unsigned u32x2 __attribute__((ext_vector_type(2)));
typedef unsigned u32x4 __attribute__((ext_vector_type(4)));
typedef __bf16 bf16x2_t __attribute__((ext_vector_type(2)));

constexpr int D = 1024, NBATCH = 4, SEQ = 4096, MP = NBATCH * SEQ, DECB = 128, DECS = 4, MS = DECB * DECS, MT = MP + MS;
constexpr int PAST = 2048, PAGE = 128, PAGES_PER_SEQ = 16;
constexpr int NH = 8, HD = 128, NKV = 2, KVW = NKV * HD, IH = 8, IDD = 64, QIW = IH * IDD, TOPK = 256;
constexpr int DFF = 4096, DPROJ = 2120, NPROJ = 2304, NMOD = 6 * D, NBROW = NBATCH + DECB;
constexpr int POOLST = 15;
constexpr float RMS_EPS = 1e-6f;
constexpr size_t O_YP = 0, O_YS = O_YP + (size_t)MP * D, O_KP = O_YS + (size_t)MS * D, O_VP = O_KP + (size_t)MP * KVW, O_KIP = O_VP + (size_t)MP * KVW,
                 O_POOLP = O_KIP + (size_t)MP * IDD, O_KS = O_POOLP + (size_t)NBATCH * POOLST * D, O_VS = O_KS + (size_t)MS * KVW, O_KIS = O_VS + (size_t)MS * KVW,
                 O_POOLS = O_KIS + (size_t)MS * IDD, O_END = O_POOLS + (size_t)DECB * POOLST * D;
constexpr size_t MiB = 1u << 20;
constexpr size_t WS_CTL = 0, CTL_ZERO_BYTES = 1 * MiB, WS_MOD = 1 * MiB, WS_SILU = 8 * MiB, WS_WIN = 9 * MiB, WS_WO = 14 * MiB, WS_WPOOL = 16 * MiB, WS_WUP = 17 * MiB,
                 WS_WDN = 33 * MiB, WS_HB = 49 * MiB, WS_QB = 82 * MiB, WS_KB = 115 * MiB, WS_VB = 124 * MiB, WS_QIB = 133 * MiB, WS_KIB = 150 * MiB, WS_WIF = 153 * MiB,
                 WS_OB = 154 * MiB, WS_X = 187 * MiB, WS_UB = 253 * MiB, WS_IL = 385 * MiB, WS_GS = 394 * MiB, WS_SHB = 396 * MiB, WS_BIAS = 397 * MiB, WS_SLAB = 405 * MiB, WS_END = 421 * MiB;
constexpr int CW_BAR = 4096, CW_SSQ = 16384;
static_assert((CW_SSQ + 4 * MT) * 4 <= (int)CTL_ZERO_BYTES, "CTL map");
constexpr int RING_BYTES = 131072, IDXL_OFF = RING_BYTES, MISC_OFF = IDXL_OFF + 4096, HIST_OFF = MISC_OFF + 256, LDS_BYTES = 147456;
static_assert(HIST_OFF + 8 * 1024 <= LDS_BYTES, "LDS map");
constexpr int NWAVES = 8, NTHREADS = 512;

#define GAS __attribute__((address_space(1)))
template <class T> __device__ __forceinline__ T* as_global(T* p) { GAS T* g = (GAS T*)p; asm volatile("" : "+s"(g)); return (T*)g; }
__device__ __forceinline__ unsigned pk2(float lo, float hi) { f32x2 v = {lo, hi}; bf16x2_t b = __builtin_convertvector(v, bf16x2_t); return __builtin_bit_cast(unsigned, b); }
__device__ __forceinline__ float bflo(unsigned u) { return __uint_as_float(u << 16); }
__device__ __forceinline__ float bfhi(unsigned u) { return __uint_as_float(u & 0xffff0000u); }
__device__ __forceinline__ bf16x8 pack8(f32x4 a, f32x4 b) { u32x4 w; w.x = pk2(a[0], a[1]); w.y = pk2(a[2], a[3]); w.z = pk2(b[0], b[1]); w.w = pk2(b[2], b[3]); return __builtin_bit_cast(bf16x8, w); }
#define LDS_WAIT() asm volatile("s_waitcnt lgkmcnt(0)" ::: "memory")
#define VM_WAIT() asm volatile("s_waitcnt vmcnt(0)" ::: "memory")

namespace pg8 {
constexpr int BM = 256, BK = 64, HALF = 128, HTB = HALF * BK * 2, STAGE_BYTES = 8 * HTB, NXCD = 8, WGM = 8;
__host__ __device__ __forceinline__ int lds_byte(int r, int c) { const int st = (r >> 4) * 2 + (c >> 5), rr = r & 15, cc = c & 31, ob = rr * 64 + cc * 2; return st * 1024 + (ob ^ (((ob >> 9) & 1) << 5)); }
__host__ __device__ __forceinline__ void stage_rc(int b, int& R, int& C) { const int st = b / 1024, sb = b % 1024, swz = sb ^ (((sb >> 9) & 1) << 5); R = (st >> 1) * 16 + swz / 64; C = (st & 1) * 32 + (swz % 64) / 2; }
__host__ __device__ __forceinline__ int perm32(int rho) { const int n = rho >> 4, i = rho & 15; return 8 * (i >> 2) + 4 * n + (i & 3); }
struct Unit { int pm, pn, k0, nt; bool atomic; };
struct Gemm { const bf16_t* A; const bf16_t* Bt; int M, N, K, lda, ldb, acol; };
struct MixOrder {
    int nMp, nMs, nN, nP, nS, S, ntFull, G, c;
    __device__ void init(int Mp, int Ms, int N, int K, int S_, int G_, int c_) { nMp = Mp / BM; nMs = Ms / BM; nN = N / BM; nP = nMp * nN; S = S_; nS = nMs * nN * S; ntFull = K / BK; G = G_; c = c_; }
    __device__ bool next(int i, Unit& u) const {
        const long L = (long)i * G + c; if (L >= nP + nS) return false;
        if (L < nP) {
            int wgid = (int)L; { const int q = nP / NXCD, r = nP % NXCD, xcd = wgid % NXCD, off = wgid / NXCD; wgid = (xcd < r ? xcd * (q + 1) : r * (q + 1) + (xcd - r) * q) + off; }
            const int nig = WGM * nN, gid = wgid / nig, fm = gid * WGM, gsz = (nMp - fm) < WGM ? (nMp - fm) : WGM;
            u.pm = fm + ((wgid % nig) % gsz); u.pn = (wgid % nig) / gsz; u.k0 = 0; u.nt = ntFull; u.atomic = false;
        } else {
            const int s_ = (int)L - nP, ks = s_ % S, q = s_ / S;
            u.pn = q % nN; u.pm = nMp + q / nN; u.nt = ntFull / S; u.k0 = ks * u.nt; u.atomic = S > 1;
        }
        return true;
    }
    __device__ __forceinline__ void a_ready(const Unit&) const {}
    __device__ __forceinline__ void done(const Unit&) const {}
};

template <class Epi, class Sched, bool ALIGN_EPI>
__device__ __forceinline__ void gemm_phase(LAS unsigned char* lds, const Gemm g, const Sched& S, const Epi& E) {
    int tid_ = threadIdx.x; asm volatile("" : "+v"(tid_));
    const int tid = tid_, wid = __builtin_amdgcn_readfirstlane(tid >> 6), lane = tid & 63, wr = wid >> 2, wc = wid & 3, fr = lane & 15, fq = lane >> 4;
    unsigned voffA[2], voffB[2];
#pragma unroll
    for (int i = 0; i < 2; ++i) { int R, C; stage_rc(tid * 16 + i * 8192, R, C); const int Rb = Epi::PERM ? ((R & ~31) + perm32(R & 31)) : R;
        voffA[i] = (unsigned)(R * g.lda + C) * 2u; voffB[i] = (unsigned)(Rb * g.ldb + C) * 2u; }
    const size_t kstep = (size_t)(BK * 2);
    const size_t hstepA = (size_t)HALF * g.lda * 2, hstepB = (size_t)HALF * g.ldb * 2;
    const size_t tstepA = 2 * hstepA, tstepB = 2 * hstepB;
    const unsigned ldsw = (unsigned)wid * 1024u;
    const int aoff = lds_byte(wr * 64 + fr, fq * 8), boff = lds_byte(wc * 32 + fr, fq * 8);
#define PG8_SA(b, h) (((b) * 2 + (h)) * HTB)
#define PG8_SB(b, h) ((4 + (b) * 2 + (h)) * HTB)
#define PG8_STAGE(bufoff, gbase, voff) do { _Pragma("unroll") for (int _i = 0; _i < 2; ++_i) \
        __builtin_amdgcn_global_load_lds((const unsigned*)((const char*)(gbase) + (voff)[_i]), (LAS unsigned*)(lds + (bufoff) + ldsw + _i * 8192), 16, 0, 0); } while (0)
#define PG8_LDA(dst, b, h) do { _Pragma("unroll") for (int m = 0; m < 4; ++m) _Pragma("unroll") for (int k = 0; k < 2; ++k) dst[m][k] = *(const LAS bf16x8*)(lds + PG8_SA(b, h) + aoff + m * 2048 + k * 1024); } while (0)
#define PG8_LDB(dst, b, h) do { _Pragma("unroll") for (int n = 0; n < 2; ++n) _Pragma("unroll") for (int k = 0; k < 2; ++k) dst[n][k] = *(const LAS bf16x8*)(lds + PG8_SB(b, h) + boff + n * 2048 + k * 1024); } while (0)
#define PG8_MMA(ai, bj, At, Bt) do { __builtin_amdgcn_s_setprio(1); _Pragma("unroll") for (int m = 0; m < 4; ++m) _Pragma("unroll") for (int n = 0; n < 2; ++n) _Pragma("unroll") for (int k = 0; k < 2; ++k) \
        acc[ai][bj][m][n] = __builtin_amdgcn_mfma_f32_16x16x32_bf16(Bt[n][k], At[m][k], acc[ai][bj][m][n], 0, 0, 0); __builtin_amdgcn_s_setprio(0); } while (0)
#define PG8_WAIT_V(n) asm volatile("s_waitcnt vmcnt(" #n ")" ::: "memory")
#define PG8_WAIT_L(n) asm volatile("s_waitcnt lgkmcnt(" #n ")" ::: "memory")
#define PG8_BAR __builtin_amdgcn_s_barrier()
#define PG8_SCHED __builtin_amdgcn_sched_barrier(0)
#define PG8_UA(u) ((const char*)g.A + (size_t)(u).pm * tstepA + (size_t)(u).pn * (size_t)g.acol * 2 + (size_t)(u).k0 * kstep)
#define PG8_UB(u) ((const char*)g.Bt + (size_t)(u).pn * tstepB + (size_t)(u).k0 * kstep)
    Unit cur, nxt; int ui = 0;
    if (!S.next(0, cur)) return;
    f32x4 acc[2][2][4][2];
#pragma unroll
    for (int a = 0; a < 2; ++a)
#pragma unroll
        for (int b = 0; b < 2; ++b)
#pragma unroll
            for (int m = 0; m < 4; ++m)
#pragma unroll
                for (int n = 0; n < 2; ++n) acc[a][b][m][n] = (f32x4){0.f, 0.f, 0.f, 0.f};
    bf16x8 At[4][2], B0[2][2], B1[2][2];
    const char* cA = PG8_UA(cur); const char* cB = PG8_UB(cur);
    S.a_ready(cur);
    PG8_STAGE(PG8_SB(0, 0), cB, voffB); PG8_STAGE(PG8_SB(0, 1), cB + hstepB, voffB); PG8_STAGE(PG8_SA(0, 0), cA, voffA); PG8_STAGE(PG8_SA(0, 1), cA + hstepA, voffA);
    if (wr == 1) PG8_BAR;
    PG8_WAIT_V(2); PG8_BAR;
    PG8_STAGE(PG8_SB(1, 0), cB + kstep, voffB); PG8_STAGE(PG8_SA(1, 0), cA + kstep, voffA); PG8_STAGE(PG8_SB(1, 1), cB + hstepB + kstep, voffB);
    PG8_WAIT_V(6); PG8_BAR;
    for (;;) {
        const bool has_next = S.next(ui + 1, nxt);
        const char* nA = has_next ? PG8_UA(nxt) : cA; const char* nB = has_next ? PG8_UB(nxt) : cB;
        const int nt = cur.nt;
        for (int t = 0; t < nt; t += 2) {
            const bool last = (t == nt - 2);
            const char* a1 = cA + (size_t)(t + 1) * kstep;
            const char* a2 = last ? nA : cA + (size_t)(t + 2) * kstep; const char* b2 = last ? nB : cB + (size_t)(t + 2) * kstep;
            const char* a3 = a2 + kstep; const char* b3 = b2 + kstep;
            if (last && has_next) S.a_ready(nxt);
            PG8_LDB(B0, 0, 0); PG8_LDB(B1, 0, 1); PG8_SCHED; PG8_LDA(At, 0, 0); PG8_STAGE(PG8_SA(1, 1), a1 + hstepA, voffA);
            PG8_WAIT_V(8); PG8_WAIT_L(0); PG8_BAR; PG8_MMA(0, 0, At, B0); PG8_MMA(0, 1, At, B1); PG8_BAR; PG8_SCHED;
            PG8_LDA(At, 0, 1); PG8_STAGE(PG8_SB(0, 0), b2, voffB); PG8_STAGE(PG8_SB(0, 1), b2 + hstepB, voffB); PG8_STAGE(PG8_SA(0, 0), a2, voffA);
            PG8_WAIT_V(8); PG8_WAIT_L(0); PG8_BAR; PG8_MMA(1, 0, At, B0); PG8_MMA(1, 1, At, B1); PG8_BAR; PG8_SCHED;
            PG8_LDB(B0, 1, 0); PG8_LDB(B1, 1, 1); PG8_SCHED; PG8_LDA(At, 1, 0); PG8_STAGE(PG8_SA(0, 1), a2 + hstepA, voffA);
            PG8_WAIT_V(8); PG8_WAIT_L(0); PG8_BAR; PG8_MMA(0, 0, At, B0); PG8_MMA(0, 1, At, B1); PG8_BAR; PG8_SCHED;
            PG8_LDA(At, 1, 1); PG8_STAGE(PG8_SB(1, 0), b3, voffB); PG8_STAGE(PG8_SB(1, 1), b3 + hstepB, voffB); PG8_STAGE(PG8_SA(1, 0), a3, voffA);
            PG8_WAIT_V(8); PG8_WAIT_L(0); PG8_BAR; PG8_MMA(1, 0, At, B0); PG8_MMA(1, 1, At, B1); PG8_BAR; PG8_SCHED;
        }
        if constexpr (ALIGN_EPI) { if (wr == 0) PG8_BAR; }
        typename Epi::Pre pre;
        E.prefetch(pre, cur, wr, wc, lane >> 2, lane & 3);
        {
            const int psrc = ((lane >> 2) + 16 * (lane & 3)) * 4;
#pragma unroll
            for (int a = 0; a < 2; ++a)
#pragma unroll
                for (int b = 0; b < 2; ++b)
#pragma unroll
                    for (int m = 0; m < 4; ++m)
#pragma unroll
                        for (int n = 0; n < 2; ++n)
                        { const f32x4 v_ = acc[a][b][m][n]; f32x4 r_;
                            r_.x = __int_as_float(__builtin_amdgcn_ds_bpermute(psrc, __float_as_int(v_.x))); r_.y = __int_as_float(__builtin_amdgcn_ds_bpermute(psrc, __float_as_int(v_.y)));
                            r_.z = __int_as_float(__builtin_amdgcn_ds_bpermute(psrc, __float_as_int(v_.z))); r_.w = __int_as_float(__builtin_amdgcn_ds_bpermute(psrc, __float_as_int(v_.w)));
                            acc[a][b][m][n] = r_; }
        }
        E(acc, pre, cur, wr, wc, lane >> 2, lane & 3); S.done(cur);
        if (!has_next) break;
#pragma unroll
        for (int a = 0; a < 2; ++a)
#pragma unroll
            for (int b = 0; b < 2; ++b)
#pragma unroll
                for (int m = 0; m < 4; ++m)
#pragma unroll
                    for (int n = 0; n < 2; ++n) acc[a][b][m][n] = (f32x4){0.f, 0.f, 0.f, 0.f};
        cur = nxt; cA = nA; cB = nB; ++ui;
        if constexpr (ALIGN_EPI) { if (wr == 1) PG8_BAR; }
    }
    PG8_WAIT_V(0);
    if constexpr (!ALIGN_EPI) { if (wr == 0) PG8_BAR; }
    PG8_BAR;
#undef PG8_SA
#undef PG8_SB
#undef PG8_STAGE
#undef PG8_LDA
#undef PG8_LDB
#undef PG8_MMA
#undef PG8_WAIT_V
#undef PG8_WAIT_L
#undef PG8_BAR
#undef PG8_SCHED
#undef PG8_UA
#undef PG8_UB
}
}

#define XB_TMO      128
#define XB_XCNT(j)  (256  + 64 * (j))
#define XB_XSUB(j)  (1280 + 64 * (j))
#define XB_XGEN(j)  (2304 + 64 * (j))
#define XB_TOP      3328
#define XB_TOPGEN   3392
#define XCD_BAR_WORDS 3456
#define XB_SPIN_CAP (1u << 18)
__device__ __forceinline__ unsigned xb_ld(unsigned* p)              { return __hip_atomic_load(p, __ATOMIC_RELAXED, __HIP_MEMORY_SCOPE_AGENT); }
__device__ __forceinline__ unsigned xb_add(unsigned* p, unsigned v) { return __hip_atomic_fetch_add(p, v, __ATOMIC_RELAXED, __HIP_MEMORY_SCOPE_AGENT); }
__device__ __forceinline__ unsigned xb_xcc_id() { return (unsigned)__builtin_amdgcn_s_getreg((3 << 11) | 20) & 0xFu; }
#define XB_SPIN(cond, bar) do { unsigned _sp = 0; while (cond) { __builtin_amdgcn_s_sleep(1); \
    if ((++_sp & 255u) == 0u) { if (xb_ld(&(bar)[XB_TMO])) break; if (_sp > XB_SPIN_CAP) { atomicAdd(&(bar)[XB_TMO], 1u); break; } } } } while (0)
struct XcdBarrier { unsigned* bar; unsigned x; volatile LAS unsigned* st; };
__device__ __forceinline__ XcdBarrier xcd_barrier_post(unsigned* bar, volatile LAS unsigned* st) {
    XcdBarrier b; b.bar = bar; b.x = xb_xcc_id(); b.st = st;
    if (threadIdx.x == 0) { st[2] = xb_add(&bar[XB_XCNT(b.x)], 1u); st[3] = b.x; }
    return b;
}
__device__ __forceinline__ void xcd_barrier_complete(unsigned* bar, unsigned x, unsigned& nloc, unsigned& nx) {
    const unsigned G = gridDim.x * gridDim.y * gridDim.z;
    unsigned sum, cnt, mine, sp = 0u;
    for (;;) {
        sum = 0u; cnt = 0u; mine = 0u;
#pragma unroll
        for (unsigned j = 0; j < 16; ++j) { const unsigned c = xb_ld(&bar[XB_XCNT(j)]); sum += c; cnt += (c > 0u) ? 1u : 0u; mine = (j == x) ? c : mine; }
        if (sum == G) break;
        __builtin_amdgcn_s_sleep(1);
        if ((++sp & 255u) == 0u) { if (xb_ld(&bar[XB_TMO])) break; if (sp > XB_SPIN_CAP) { atomicAdd(&bar[XB_TMO], 1u); break; } }
    }
    nloc = mine > 0u ? mine : 1u; nx = cnt > 0u ? cnt : 1u;
}
__device__ __forceinline__ void xcd_barrier(const XcdBarrier& b) {
    asm volatile("s_waitcnt vmcnt(0)" ::: "memory");
    __syncthreads();
    if (threadIdx.x == 0) {
        unsigned* bar = b.bar;
        __builtin_amdgcn_s_waitcnt(0);
        unsigned nloc = b.st[0], nx = b.st[1];
        if (nloc == 0u) { xcd_barrier_complete(bar, b.x, nloc, nx); b.st[0] = nloc; b.st[1] = nx; }
        const unsigned old = xb_add(&bar[XB_XSUB(b.x)], 1u);
        const unsigned gen = old / nloc;
        if (old + 1u == (gen + 1u) * nloc) {
            __builtin_amdgcn_fence(__ATOMIC_RELEASE, "agent");
            asm volatile("s_waitcnt vmcnt(0)" ::: "memory");
            const unsigned og = xb_add(&bar[XB_TOP], 1u);
            const unsigned tg = og / nx;
            if (og + 1u == (tg + 1u) * nx) xb_add(&bar[XB_TOPGEN], 1u);
            else XB_SPIN(xb_ld(&bar[XB_TOPGEN]) == tg, bar);
            __builtin_amdgcn_fence(__ATOMIC_ACQUIRE, "agent");
            xb_add(&bar[XB_XGEN(b.x)], 1u);
            asm volatile("s_waitcnt vmcnt(0)" ::: "memory");
        } else {
            XB_SPIN(xb_ld(&bar[XB_XGEN(b.x)]) == gen, bar);
            __builtin_amdgcn_fence(__ATOMIC_ACQUIRE, "agent");
            asm volatile("s_waitcnt vmcnt(0)" ::: "memory");
        }
    }
    __syncthreads();
}

struct Params { const float* in[20]; float* out; unsigned char* ws; };
struct Frame {
    LAS unsigned char* lds;
    int tid, lane, wave, G, bid;
    const float *x_p, *x_s, *cache_k, *cache_v, *cache_ki, *state_pool, *c_p, *c_s, *g_mix, *g_ffn, *w_mod, *b_mod, *w_in, *w_o, *pool_w, *pool_scale, *w_up, *w_down, *g_final;
    const int* page_table;
    float* out; unsigned char* ws;
    float* MOD; bf16_t *SILU, *WIN, *WO, *WPOOL, *WUP, *WDN, *HB, *QB, *KB, *VB, *QIB, *KIB, *OB, *UB; float *WIF, *X; unsigned short* ILG; float *GS, *BIAS, *SSQ, *SLAB; bf16_t* SHB;
};
__device__ __forceinline__ int brow_of(int r) { return r < MP ? (r >> 12) : NBATCH + ((r - MP) >> 2); }

struct NoPre {};
struct EpiProj {
    static constexpr bool PERM = true;
    typedef NoPre Pre;
    __device__ __forceinline__ void prefetch(Pre&, const pg8::Unit&, int, int, int, int) const {}
    bf16_t *QB, *KB, *VB, *QIB, *KIB; float* WIF; float* out;
    __device__ __forceinline__ void operator()(const f32x4 (&acc)[2][2][4][2], const Pre&, const pg8::Unit& u, int wr, int wc, int fr, int fq) const {
        const int pn = u.pn;
#pragma unroll
        for (int ai = 0; ai < 2; ++ai)
#pragma unroll
            for (int m = 0; m < 4; ++m) {
                const int row = u.pm * 256 + ai * 128 + wr * 64 + m * 16 + fr;
#pragma unroll
                for (int bj = 0; bj < 2; ++bj) {
                    const int cl = bj * 128 + wc * 32 + 8 * fq;
                    const f32x4 v0 = acc[ai][bj][m][0], v1 = acc[ai][bj][m][1];
                    const bf16x8 pk = pack8(v0, v1);
                    if (pn < 4) { *(bf16x8*)(QB + (size_t)row * D + pn * 256 + cl) = pk; }
                    else if (pn == 4 || pn == 5) {
                        bf16_t* B = pn == 4 ? KB : VB; *(bf16x8*)(B + (size_t)row * KVW + cl) = pk;
                        float* o = out + (row < MP ? (pn == 4 ? O_KP : O_VP) + (size_t)row * KVW : (pn == 4 ? O_KS : O_VS) + (size_t)(row - MP) * KVW) + cl;
                        *(f32x4*)o = v0; *(f32x4*)(o + 4) = v1;
                    } else if (pn < 8) { *(bf16x8*)(QIB + (size_t)row * QIW + (pn - 6) * 256 + cl) = pk; }
                    else {
                        if (cl < 64) { *(bf16x8*)(KIB + (size_t)(row >> 5) * (32 * IDD) + ((cl >> 3) * 32 + (row & 31)) * 8) = pk;
                            float* o = out + (row < MP ? O_KIP + (size_t)row * IDD : O_KIS + (size_t)(row - MP) * IDD) + cl; *(f32x4*)o = v0; *(f32x4*)(o + 4) = v1; }
                        else if (cl == 64) { float* o = WIF + (size_t)row * 8; *(f32x4*)o = v0; *(f32x4*)(o + 4) = v1; }
                    }
                }
            }
    }
};
struct EpiUp {
    static constexpr bool PERM = true;
    bf16_t* UB; const float* ssq; const float* bias;
    struct Pre { float rs[2][4]; };
    __device__ __forceinline__ void prefetch(Pre& p, const pg8::Unit& u, int wr, int wc, int fr, int fq) const {
        const int row0 = u.pm * 256 + wr * 64 + fr;
#pragma unroll
        for (int ai = 0; ai < 2; ++ai)
#pragma unroll
            for (int m = 0; m < 4; ++m) p.rs[ai][m] = ssq[row0 + ai * 128 + m * 16];
    }
    __device__ __forceinline__ void operator()(const f32x4 (&acc)[2][2][4][2], const Pre& p, const pg8::Unit& u, int wr, int wc, int fr, int fq) const {
        f32x4 bv[2][2];
        const int row0 = u.pm * 256 + wr * 64 + fr, col0 = u.pn * 256 + wc * 32 + 8 * fq;
        const bool uni = u.pm < MP / 256;
        if (uni) { const float* br = bias + (size_t)(row0 >> 12) * DFF + col0;
#pragma unroll
            for (int bj = 0; bj < 2; ++bj) { bv[bj][0] = *(const f32x4*)(br + bj * 128); bv[bj][1] = *(const f32x4*)(br + bj * 128 + 4); } }
#pragma unroll
        for (int ai = 0; ai < 2; ++ai)
#pragma unroll
            for (int m = 0; m < 4; ++m) {
                const int row = row0 + ai * 128 + m * 16;
                const float rs = uni ? __builtin_amdgcn_rsqf(p.rs[ai][m] * (1.f / D) + RMS_EPS) : 1.0f;
                if (!uni) {
#pragma unroll
                    for (int bj = 0; bj < 2; ++bj) { bv[bj][0] = (f32x4){0.f, 0.f, 0.f, 0.f}; bv[bj][1] = (f32x4){0.f, 0.f, 0.f, 0.f}; } }
#pragma unroll
                for (int bj = 0; bj < 2; ++bj) {
                    f32x4 v0 = acc[ai][bj][m][0] * rs + bv[bj][0], v1 = acc[ai][bj][m][1] * rs + bv[bj][1];
#pragma unroll
                    for (int j = 0; j < 4; ++j) { const float a = __builtin_amdgcn_fmed3f(v0[j], 0.f, __builtin_inff()), b = __builtin_amdgcn_fmed3f(v1[j], 0.f, __builtin_inff()); v0[j] = a * a; v1[j] = b * b; }
                    *(bf16x8*)(UB + (size_t)row * DFF + col0 + bj * 128) = pack8(v0, v1);
                }
            }
    }
};
struct EpiBias {
    static constexpr bool PERM = false;
    typedef NoPre Pre;
    __device__ __forceinline__ void prefetch(Pre&, const pg8::Unit&, int, int, int, int) const {}
    float* B;
    __device__ __forceinline__ void operator()(const f32x4 (&acc)[2][2][4][2], const Pre&, const pg8::Unit& u, int wr, int wc, int fr, int fq) const {
#pragma unroll
        for (int ai = 0; ai < 2; ++ai)
#pragma unroll
            for (int m = 0; m < 4; ++m) {
                const int row = u.pm * 256 + ai * 128 + wr * 64 + m * 16 + fr;
#pragma unroll
                for (int bj = 0; bj < 2; ++bj)
#pragma unroll
                    for (int n = 0; n < 2; ++n) { const int c = (u.pn & 15) * 256 + bj * 128 + wc * 32 + 16 * n + 4 * fq; *(f32x4*)(B + (size_t)row * DFF + c) = acc[ai][bj][m][n]; }
            }
    }
};
template <int FUSE, bool XFRAG> struct EpiRes {
    static constexpr bool PERM = false;
    const float *xin_p, *xin_s;
    float* X; const float* gate;
    const float* cscale;
    const float* gs; bf16_t* XG; float* ssq; bool xin_frag; float* slab;
    struct Pre { u32x4 xw[XFRAG ? 4 : 1]; };
    __device__ __forceinline__ void prefetch(Pre& p, const pg8::Unit& u, int wr, int wc, int fr, int fq) const {
        if (!XFRAG || u.atomic || u.pm >= MP / 256) return;
        if (XFRAG) { const bf16_t* xb = (const bf16_t*)xin_p + ((size_t)((u.pm * 4 + u.pn) * 8 + wr * 4 + wc) * 16) * 512 + (size_t)(4 * fr + fq) * 8;
#pragma unroll
            for (int i = 0; i < 4; ++i) p.xw[i] = *(const u32x4*)(xb + (size_t)i * 512); }
    }
    __device__ __forceinline__ void operator()(const f32x4 (&acc)[2][2][4][2], const Pre& p, const pg8::Unit& u, int wr, int wc, int fr, int fq) const {
        const int row0 = u.pm * 256 + wr * 64 + fr, col0 = u.pn * 256 + wc * 32 + 4 * fq;
        if (u.atomic) {
            float* sl = slab + (size_t)(u.k0 / u.nt) * MS * D;
#pragma unroll
            for (int ai = 0; ai < 2; ++ai)
#pragma unroll
                for (int m = 0; m < 4; ++m) { const int row = row0 + ai * 128 + m * 16; const float* gr = gate + (size_t)brow_of(row) * NMOD;
#pragma unroll
                    for (int bj = 0; bj < 2; ++bj)
#pragma unroll
                        for (int n = 0; n < 2; ++n) { const int c = col0 + bj * 128 + 16 * n; f32x4 a = acc[ai][bj][m][n] * *(const f32x4*)(gr + c); if (cscale) a = a * *(const f32x4*)(cscale + c);
                            *(f32x4*)(sl + (size_t)(row - MP) * D + c) = a; } }
            return;
        }
        const bool uni = u.pm < MP / 256;
        const size_t fbase = ((size_t)((u.pm * 4 + u.pn) * 8 + wr * 4 + wc) * 16) * 512 + (size_t)(4 * fr + fq) * 8;
        bf16_t* XB = (bf16_t*)X;
        f32x4 gv[2][2], sv[2][2];
#pragma unroll
        for (int bj = 0; bj < 2; ++bj)
#pragma unroll
            for (int n = 0; n < 2; ++n) { const int c = col0 + bj * 128 + 16 * n; const int br = row0 >> 12;
                gv[bj][n] = *(const f32x4*)(gate + (size_t)br * NMOD + c); if (cscale) gv[bj][n] = gv[bj][n] * *(const f32x4*)(cscale + c);
                if (FUSE == 1) sv[bj][n] = *(const f32x4*)(gs + (size_t)br * D + c); }
#pragma unroll
        for (int g2 = 0; g2 < 4; ++g2) {
            const int ai = g2 >> 1;
            f32x4 xr[2][2][2]; u32x4 xw[2][2];
#pragma unroll
            for (int mm = 0; mm < 2; ++mm) { const int m_ = (g2 & 1) * 2 + mm; const int row = row0 + ai * 128 + m_ * 16;
#pragma unroll
                for (int bj = 0; bj < 2; ++bj) {
                    if (XFRAG) xw[mm][bj] = g2 == 0 ? p.xw[m_ * 2 + bj] : *(const u32x4*)((const bf16_t*)xin_p + fbase + (size_t)(((ai * 4 + m_) * 2 + bj) * 512));
                    else {
#pragma unroll
                        for (int n = 0; n < 2; ++n) xr[mm][bj][n] = *(const f32x4*)(xin_p + (size_t)row * D + col0 + bj * 128 + 16 * n); } } }
#pragma unroll
            for (int mm = 0; mm < 2; ++mm) {
                const int m = (g2 & 1) * 2 + mm;
                const int row = row0 + ai * 128 + m * 16;
                float sq = 0.f;
#pragma unroll
                for (int bj = 0; bj < 2; ++bj) {
                    f32x4 o2[2];
#pragma unroll
                    for (int n = 0; n < 2; ++n) {
                        f32x4 xv;
                        if (XFRAG) { const unsigned lo_ = n == 0 ? xw[mm][bj].x : xw[mm][bj].z, hi_ = n == 0 ? xw[mm][bj].y : xw[mm][bj].w; xv = (f32x4){bflo(lo_), bfhi(lo_), bflo(hi_), bfhi(hi_)}; }
                        else xv = xr[mm][bj][n];
                        const f32x4 o = xv + acc[ai][bj][m][n] * gv[bj][n]; o2[n] = o;
                        if (FUSE != 0) sq += (o[0] * o[0] + o[1] * o[1]) + (o[2] * o[2] + o[3] * o[3]);
                        if (FUSE == 1) { const f32x4 g = o * sv[bj][n]; u32x2 w2; w2.x = pk2(g[0], g[1]); w2.y = pk2(g[2], g[3]); *(u32x2*)(XG + (size_t)row * D + col0 + bj * 128 + 16 * n) = w2; }
                    }
                    *(bf16x8*)(XB + fbase + (size_t)(((ai * 4 + m) * 2 + bj) * 512)) = pack8(o2[0], o2[1]);
                }
                if (FUSE != 0) { sq += __shfl_xor(sq, 1); sq += __shfl_xor(sq, 2); if (fq == 0) (void)__hip_atomic_fetch_add(ssq + row, sq, __ATOMIC_RELAXED, __HIP_MEMORY_SCOPE_AGENT); }
            }
        }
    }
};
struct BiasOrder {
    int c;
    __device__ bool next(int i, pg8::Unit& u) const { if (i != 0 || c < 96 || c >= 128) return false; u.pm = (c - 96) >> 4; u.pn = c - 96; u.k0 = 0; u.nt = D / 64; u.atomic = false; return true; }
    __device__ __forceinline__ void a_ready(const pg8::Unit&) const {}
    __device__ __forceinline__ void done(const pg8::Unit&) const {}
};

__device__ __forceinline__ float wave_sum(float v) {
#pragma unroll
    for (int o = 1; o < 64; o <<= 1) v += __shfl_xor(v, o);
    return v;
}
template <int CTRL> __device__ __forceinline__ unsigned dpp_u(unsigned v) { return (unsigned)__builtin_amdgcn_update_dpp(0, (int)v, CTRL, 0xf, 0xf, true); }
__device__ __forceinline__ unsigned wave_sum_u(unsigned v) {
    v += dpp_u<0xB1>(v); v += dpp_u<0x4E>(v); v += dpp_u<0x141>(v); v += dpp_u<0x140>(v);
    return (unsigned)__builtin_amdgcn_readlane((int)v, 0) + (unsigned)__builtin_amdgcn_readlane((int)v, 16) + (unsigned)__builtin_amdgcn_readlane((int)v, 32) + (unsigned)__builtin_amdgcn_readlane((int)v, 48);
}
__device__ __forceinline__ unsigned wave_max_u(unsigned v) {
    unsigned t;
    t = dpp_u<0xB1>(v); v = v > t ? v : t; t = dpp_u<0x4E>(v); v = v > t ? v : t; t = dpp_u<0x141>(v); v = v > t ? v : t; t = dpp_u<0x140>(v); v = v > t ? v : t;
    const unsigned a = (unsigned)__builtin_amdgcn_readlane((int)v, 0), b = (unsigned)__builtin_amdgcn_readlane((int)v, 16), c = (unsigned)__builtin_amdgcn_readlane((int)v, 32), d = (unsigned)__builtin_amdgcn_readlane((int)v, 48);
    const unsigned ab = a > b ? a : b, cd = c > d ? c : d; return ab > cd ? ab : cd;
}

__device__ __forceinline__ void transpose_item(const float* W, int N, bf16_t* WT, int ldo, int row_off, LAS float* scr, int kb, int nb, int lane) {
    const int k0 = 64 * kb, n0 = 32 * nb;
    const int n = n0 + 4 * (lane & 7);
    f32x4 v[8];
#pragma unroll
    for (int i = 0; i < 8; ++i) { const int kk = 8 * i + (lane >> 3); v[i] = (n < N) ? *(const f32x4*)(W + (size_t)(k0 + kk) * N + n) : (f32x4){0.f, 0.f, 0.f, 0.f}; }
#pragma unroll
    for (int i = 0; i < 8; ++i) { const int kk = 8 * i + (lane >> 3); LAS float* d = scr + kk * 33 + 4 * (lane & 7); d[0] = v[i][0]; d[1] = v[i][1]; d[2] = v[i][2]; d[3] = v[i][3]; }
    LDS_WAIT(); asm volatile("" ::: "memory");
    const int c = lane & 7;
#pragma unroll
    for (int j = 0; j < 4; ++j) { const int nn = (lane >> 3) + 8 * j; const LAS float* s = scr + (8 * c) * 33 + nn;
        u32x4 o; o.x = pk2(s[0 * 33], s[1 * 33]); o.y = pk2(s[2 * 33], s[3 * 33]); o.z = pk2(s[4 * 33], s[5 * 33]); o.w = pk2(s[6 * 33], s[7 * 33]);
        *(u32x4*)(WT + (size_t)(row_off + n0 + nn) * ldo + k0 + 8 * c) = o; }
    LDS_WAIT(); asm volatile("" ::: "memory");
}

constexpr int CW_SILU = 8192;
__device__ __forceinline__ void p0_mod_task(Frame& F, int task, unsigned* flag) {
    const int col = F.lane & 15, kq = F.lane >> 4;
    const int l = task / (NMOD / 16), n0 = (task % (NMOD / 16)) * 16;
    const float* W = F.w_mod + (size_t)l * D * NMOD + n0 + col;
    f32x4 acc[9];
#pragma unroll
    for (int i = 0; i < 9; ++i) acc[i] = (f32x4){0.f, 0.f, 0.f, 0.f};
    { unsigned sp = 0; while (__hip_atomic_load(flag, __ATOMIC_RELAXED, __HIP_MEMORY_SCOPE_AGENT) < 144u) { __builtin_amdgcn_s_sleep(4); if (++sp > (1u << 22)) break; }
      __builtin_amdgcn_fence(__ATOMIC_ACQUIRE, "agent"); asm volatile("s_waitcnt vmcnt(0)" ::: "memory"); }
    float f0[8], f1[8]; bf16x8 a0[9], a1[9];
#define MOD_LOAD(f, a, ks) do { const int k0_ = 32 * (ks) + 8 * kq; _Pragma("unroll") for (int j = 0; j < 8; ++j) f[j] = W[(size_t)(k0_ + j) * NMOD]; \
        _Pragma("unroll") for (int mt = 0; mt < 9; ++mt) a[mt] = *(const bf16x8*)(F.SILU + (size_t)(16 * mt + col) * D + k0_); } while (0)
#define MOD_MMA(f, a) do { u32x4 bw; bw.x = pk2(f[0], f[1]); bw.y = pk2(f[2], f[3]); bw.z = pk2(f[4], f[5]); bw.w = pk2(f[6], f[7]); const bf16x8 bfr = __builtin_bit_cast(bf16x8, bw); \
        _Pragma("unroll") for (int mt = 0; mt < 9; ++mt) acc[mt] = __builtin_amdgcn_mfma_f32_16x16x32_bf16(a[mt], bfr, acc[mt], 0, 0, 0); } while (0)
    MOD_LOAD(f0, a0, 0);
    for (int ks = 0; ks < D / 32; ks += 2) {
        MOD_LOAD(f1, a1, ks + 1);
        MOD_MMA(f0, a0);
        if (ks + 2 < D / 32) MOD_LOAD(f0, a0, ks + 2);
        MOD_MMA(f1, a1);
    }
#undef MOD_LOAD
#undef MOD_MMA
    const float bias = F.b_mod[(size_t)l * NMOD + n0 + col];
#pragma unroll
    for (int mt = 0; mt < 9; ++mt)
#pragma unroll
        for (int r = 0; r < 4; ++r) { const int row = 16 * mt + 4 * kq + r; if (row < NBROW) F.MOD[((size_t)l * NBROW + row) * NMOD + n0 + col] = acc[mt][r] + bias; }
}
__device__ __forceinline__ void p0(Frame& F) {
    LAS float* scr = (LAS float*)(F.lds + F.wave * 16384);
    unsigned* flag = (unsigned*)(F.ws + WS_CTL) + CW_SILU;
    const int gw = F.bid * NWAVES + F.wave, NGW = F.G * NWAVES;
    constexpr int I_IN = (D / 64) * (NPROJ / 32), I_O = (D / 64) * (D / 32), I_P = 4 * (256 / 64) * (256 / 32), I_UP = (D / 64) * (DFF / 32), I_DN = (DFF / 64) * (D / 32);
    constexpr int N_SILU = 144, N_MOD = 2 * (NMOD / 16);
    constexpr int NIT = N_SILU + N_MOD + I_IN + I_O + I_P + 2 * I_UP + 2 * I_DN;
    for (int it = gw; it < NIT; it += NGW) {
        int r = it;
        if (r < N_SILU) {
            const float* c = r < NBATCH ? F.c_p + (size_t)r * D : F.c_s + (size_t)(r - NBATCH) * D;
#pragma unroll
            for (int j = 0; j < 4; ++j) {
                f32x4 v = {0.f, 0.f, 0.f, 0.f};
                if (r < NBROW) { v = *(const f32x4*)(c + 4 * F.lane + 256 * j);
#pragma unroll
                    for (int e = 0; e < 4; ++e) v[e] = v[e] * __builtin_amdgcn_rcpf(1.f + __expf(-v[e])); }
                u32x2 o; o.x = pk2(v[0], v[1]); o.y = pk2(v[2], v[3]);
                *(u32x2*)(F.SILU + (size_t)r * D + 4 * F.lane + 256 * j) = o;
            }
            asm volatile("s_waitcnt vmcnt(0)" ::: "memory");
            if (F.lane == 0) { __builtin_amdgcn_fence(__ATOMIC_RELEASE, "agent"); asm volatile("s_waitcnt vmcnt(0)" ::: "memory"); (void)__hip_atomic_fetch_add(flag, 1u, __ATOMIC_RELAXED, __HIP_MEMORY_SCOPE_AGENT); }
            continue;
        } r -= N_SILU;
        if (r < N_MOD) { p0_mod_task(F, r, flag); continue; } r -= N_MOD;
        if (r < I_IN) { transpose_item(F.w_in, DPROJ, F.WIN, D, 0, scr, r / (NPROJ / 32), r % (NPROJ / 32), F.lane); continue; } r -= I_IN;
        if (r < I_O) { transpose_item(F.w_o, D, F.WO, D, 0, scr, r / (D / 32), r % (D / 32), F.lane); continue; } r -= I_O;
        if (r < I_P) { const int g = r / 32, q = r % 32; transpose_item(F.pool_w + (size_t)g * 65536, 256, F.WPOOL, 256, g * 256, scr, q / 8, q % 8, F.lane); continue; } r -= I_P;
        if (r < 2 * I_UP) { const int l = r / I_UP, q = r % I_UP; transpose_item(F.w_up + (size_t)l * D * DFF, DFF, F.WUP + (size_t)l * D * DFF, D, 0, scr, q / (DFF / 32), q % (DFF / 32), F.lane); continue; } r -= 2 * I_UP;
        { const int l = r / I_DN, q = r % I_DN; transpose_item(F.w_down + (size_t)l * D * DFF, D, F.WDN + (size_t)l * D * DFF, DFF, 0, scr, q / (D / 32), q % (D / 32), F.lane); }
    }
}

__device__ __forceinline__ void rowpass_first(Frame& F, const float* mod_l) {
    const int gw = F.bid * NWAVES + F.wave, NGW = F.G * NWAVES;
    for (int r0 = gw * 4; r0 < MT; r0 += NGW * 4) {
        const float* xr = r0 < MP ? F.x_p + (size_t)r0 * D : F.x_s + (size_t)(r0 - MP) * D;
        f32x4 v[4][4];
#pragma unroll
        for (int q = 0; q < 4; ++q)
#pragma unroll
            for (int j = 0; j < 4; ++j) v[q][j] = *(const f32x4*)(xr + (size_t)q * D + 4 * F.lane + 256 * j);
        const float* mr = mod_l + (size_t)brow_of(r0) * NMOD;
        f32x4 gsv[4], shv[4];
#pragma unroll
        for (int j = 0; j < 4; ++j) { const int c = 4 * F.lane + 256 * j; gsv[j] = *(const f32x4*)(F.g_mix + c) * (*(const f32x4*)(mr + D + c) + 1.0f); shv[j] = *(const f32x4*)(mr + c); }
#pragma unroll
        for (int q = 0; q < 4; ++q) {
            float ss = 0.f;
#pragma unroll
            for (int j = 0; j < 4; ++j) ss += (v[q][j].x * v[q][j].x + v[q][j].y * v[q][j].y) + (v[q][j].z * v[q][j].z + v[q][j].w * v[q][j].w);
            const float rstd = __builtin_amdgcn_rsqf(wave_sum(ss) * (1.f / D) + RMS_EPS);
#pragma unroll
            for (int j = 0; j < 4; ++j) { const int c = 4 * F.lane + 256 * j; const f32x4 h = v[q][j] * rstd * gsv[j] + shv[j];
                u32x2 o; o.x = pk2(h[0], h[1]); o.y = pk2(h[2], h[3]); *(u32x2*)(F.HB + (size_t)(r0 + q) * D + c) = o;
                if (r0 >= MP) *(f32x4*)(F.X + (size_t)(r0 + q) * D + c) = v[q][j]; }
        }
    }
    for (int it = gw; it < 3 * NBROW + 2 * 256; it += NGW) {
        if (it < 3 * NBROW) { const int inst = it / NBROW, br = it % NBROW;
            const float* g = inst == 0 ? F.g_ffn : inst == 1 ? F.g_mix + D : F.g_ffn + D;
            const float* sc = F.MOD + ((size_t)(inst == 0 ? 0 : 1) * NBROW + br) * NMOD + (inst == 1 ? 1 : 4) * D;
#pragma unroll
            for (int j = 0; j < 4; ++j) { const int c = 4 * F.lane + 256 * j; *(f32x4*)(F.GS + ((size_t)inst * NBROW + br) * D + c) = *(const f32x4*)(g + c) * (*(const f32x4*)(sc + c) + 1.0f); }
        } else { const int q = it - 3 * NBROW, l = q >> 8, br = q & 255;
#pragma unroll
            for (int j = 0; j < 4; ++j) { const int c = 4 * F.lane + 256 * j; f32x4 v = {0.f, 0.f, 0.f, 0.f}; if (br < NBROW) v = *(const f32x4*)(F.MOD + ((size_t)l * NBROW + br) * NMOD + 3 * D + c);
                u32x2 o; o.x = pk2(v[0], v[1]); o.y = pk2(v[2], v[3]); *(u32x2*)(F.SHB + ((size_t)l * 256 + br) * D + c) = o; }
        }
    }
}
template <int MODE>
__device__ __forceinline__ void rowpass(Frame& F, const float* src_p, const float* src_s, const float* gain, const float* mod_l, int sh_chunk, int sc_chunk, bf16_t* dst) {
    const int gw = F.bid * NWAVES + F.wave, NGW = F.G * NWAVES;
    for (int r = gw; r < MT; r += NGW) {
        const float* xr = r < MP ? src_p + (size_t)r * D : src_s + (size_t)(r - MP) * D;
        f32x4 v[4]; float s = 0.f;
#pragma unroll
        for (int j = 0; j < 4; ++j) { v[j] = *(const f32x4*)(xr + 4 * F.lane + 256 * j); s += (v[j].x * v[j].x + v[j].y * v[j].y) + (v[j].z * v[j].z + v[j].w * v[j].w); }
        const float rstd = (MODE == 2 && r < MP) ? __builtin_amdgcn_rsqf(F.SSQ[3 * MT + r] * (1.f / D) + RMS_EPS) : __builtin_amdgcn_rsqf(wave_sum(s) * (1.f / D) + RMS_EPS);
        if (MODE == 2) {
            float* o = r < MP ? F.out + O_YP + (size_t)r * D : F.out + O_YS + (size_t)(r - MP) * D;
#pragma unroll
            for (int j = 0; j < 4; ++j) { const int c = 4 * F.lane + 256 * j; *(f32x4*)(o + c) = v[j] * rstd * *(const f32x4*)(gain + c); }
        } else {
            const float* mr = mod_l + (size_t)brow_of(r) * NMOD;
            float* po = nullptr;
            if (MODE == 1) {
                if (r < MP) { const int t = r & (SEQ - 1); if (t >= SEQ - POOLST) po = F.out + O_POOLP + ((size_t)(r >> 12) * POOLST + (t - (SEQ - POOLST))) * D; }
                else { const int q = r - MP; po = F.out + O_POOLS + ((size_t)(q >> 2) * POOLST + (POOLST - DECS) + (q & 3)) * D; }
            }
#pragma unroll
            for (int j = 0; j < 4; ++j) { const int c = 4 * F.lane + 256 * j;
                const f32x4 h = v[j] * rstd * *(const f32x4*)(gain + c) * (*(const f32x4*)(mr + sc_chunk * D + c) + 1.0f) + *(const f32x4*)(mr + sh_chunk * D + c);
                u32x2 o; o.x = pk2(h[0], h[1]); o.y = pk2(h[2], h[3]);
                *(u32x2*)(dst + (size_t)r * D + c) = o;
                if (MODE == 3 && r >= MP) *(f32x4*)(F.X + (size_t)r * D + c) = v[j];
                if (MODE == 1 && po) *(f32x4*)(po + c) = h; }
        }
    }
    if (MODE == 3) {
        for (int it = gw; it < 3 * NBROW + 2 * 256; it += NGW) {
            if (it < 3 * NBROW) { const int inst = it / NBROW, br = it % NBROW;
                const float* g = inst == 0 ? F.g_ffn : inst == 1 ? F.g_mix + D : F.g_ffn + D;
                const float* sc = F.MOD + ((size_t)(inst == 0 ? 0 : 1) * NBROW + br) * NMOD + (inst == 1 ? 1 : 4) * D;
#pragma unroll
                for (int j = 0; j < 4; ++j) { const int c = 4 * F.lane + 256 * j; *(f32x4*)(F.GS + ((size_t)inst * NBROW + br) * D + c) = *(const f32x4*)(g + c) * (*(const f32x4*)(sc + c) + 1.0f); }
            } else { const int q = it - 3 * NBROW, l = q >> 8, br = q & 255;
#pragma unroll
                for (int j = 0; j < 4; ++j) { const int c = 4 * F.lane + 256 * j; f32x4 v = {0.f, 0.f, 0.f, 0.f}; if (br < NBROW) v = *(const f32x4*)(F.MOD + ((size_t)l * NBROW + br) * NMOD + 3 * D + c);
                    u32x2 o; o.x = pk2(v[0], v[1]); o.y = pk2(v[2], v[3]); *(u32x2*)(F.SHB + ((size_t)l * 256 + br) * D + c) = o; }
            }
        }
    }
    if (MODE == 1) {
        for (int it = gw; it < DECB * (POOLST - DECS); it += NGW) { const int seq = it / (POOLST - DECS), i = it % (POOLST - DECS);
            const float* s = F.state_pool + ((size_t)seq * POOLST + i + DECS) * D; float* o = F.out + O_POOLS + ((size_t)seq * POOLST + i) * D;
#pragma unroll
            for (int j = 0; j < 4; ++j) *(f32x4*)(o + 4 * F.lane + 256 * j) = *(const f32x4*)(s + 4 * F.lane + 256 * j); }
    }
}

__device__ __forceinline__ void finalpass(Frame& F) {
    const int gw = F.bid * NWAVES + F.wave, NGW = F.G * NWAVES;
    const float* ssq = F.SSQ + 3 * MT;
    const int fr = F.lane >> 2, fq = F.lane & 3;
#pragma unroll 4
    for (int it = gw; it < (MP / 256) * 4 * 8 * 8; it += NGW) {
        const int am = it & 7, wid = (it >> 3) & 7, tile = it >> 6, pm = tile >> 2, pn = tile & 3, wr = wid >> 2, wc = wid & 3;
        const int row = pm * 256 + (am >> 2) * 128 + wr * 64 + (am & 3) * 16 + fr;
        const float rs = __builtin_amdgcn_rsqf(ssq[row] * (1.f / D) + RMS_EPS);
        const bf16_t* xb = (const bf16_t*)F.X + ((size_t)(tile * 8 + wid) * 16 + am * 2) * 512 + F.lane * 8;
        f32x4 v[4];
#pragma unroll
        for (int bj = 0; bj < 2; ++bj) { const u32x4 w4 = *(const u32x4*)(xb + bj * 512);
            v[2 * bj] = (f32x4){bflo(w4.x), bfhi(w4.x), bflo(w4.y), bfhi(w4.y)}; v[2 * bj + 1] = (f32x4){bflo(w4.z), bfhi(w4.z), bflo(w4.w), bfhi(w4.w)}; }
#pragma unroll
        for (int q = 0; q < 4; ++q) { const int c = pn * 256 + (q >> 1) * 128 + wc * 32 + 16 * (q & 1) + 4 * fq;
            *(f32x4*)(F.out + O_YP + (size_t)row * D + c) = v[q] * rs * *(const f32x4*)(F.g_final + c); }
    }
    for (int r = gw; r < MS; r += NGW) {
        const float* xr = F.X + (size_t)(MP + r) * D;
        f32x4 v[4]; float s = 0.f;
#pragma unroll
        for (int j = 0; j < 4; ++j) { const int c = 4 * F.lane + 256 * j; v[j] = *(const f32x4*)(xr + c);
#pragma unroll
            for (int ks = 0; ks < 8; ++ks) v[j] += *(const f32x4*)(F.SLAB + ((size_t)ks * MS + r) * D + c);
            s += (v[j].x * v[j].x + v[j].y * v[j].y) + (v[j].z * v[j].z + v[j].w * v[j].w); }
        const float rstd = __builtin_amdgcn_rsqf(wave_sum(s) * (1.f / D) + RMS_EPS);
#pragma unroll
        for (int j = 0; j < 4; ++j) { const int c = 4 * F.lane + 256 * j; *(f32x4*)(F.out + O_YS + (size_t)r * D + c) = v[j] * rstd * *(const f32x4*)(F.g_final + c); }
    }
}

__device__ __forceinline__ void samplefix(Frame& F, const float* xin, int nslab, const float* gain, const float* mod_l) {
    const int gw = F.wave * F.G + F.bid, NGW = F.G * NWAVES;
    for (int r = gw; r < MS; r += NGW) {
        f32x4 v[4]; float sq = 0.f;
#pragma unroll
        for (int j = 0; j < 4; ++j) { const int c = 4 * F.lane + 256 * j; v[j] = *(const f32x4*)(xin + (size_t)r * D + c); }
        for (int ks = 0; ks < nslab; ++ks)
#pragma unroll
            for (int j = 0; j < 4; ++j) v[j] += *(const f32x4*)(F.SLAB + ((size_t)ks * MS + r) * D + 4 * F.lane + 256 * j);
#pragma unroll
        for (int j = 0; j < 4; ++j) { *(f32x4*)(F.X + (size_t)(MP + r) * D + 4 * F.lane + 256 * j) = v[j]; sq += (v[j].x * v[j].x + v[j].y * v[j].y) + (v[j].z * v[j].z + v[j].w * v[j].w); }
        const float rstd = __builtin_amdgcn_rsqf(wave_sum(sq) * (1.f / D) + RMS_EPS);
        const float* mr = mod_l + (size_t)(NBATCH + (r >> 2)) * NMOD;
#pragma unroll
        for (int j = 0; j < 4; ++j) { const int c = 4 * F.lane + 256 * j;
            const f32x4 h = v[j] * rstd * *(const f32x4*)(gain + c) * (*(const f32x4*)(mr + 4 * D + c) + 1.0f) + *(const f32x4*)(mr + 3 * D + c);
            u32x2 o; o.x = pk2(h[0], h[1]); o.y = pk2(h[2], h[3]); *(u32x2*)(F.HB + (size_t)(MP + r) * D + c) = o; }
    }
}

__device__ __forceinline__ void poolpass(Frame& F, const bf16_t* XG, const float* ssq, const float* mod_l, bf16_t* PB) {
    const bool ded = F.G >= 2 * DECB;
    const bool smp_wave = ded && F.bid < DECB && F.wave == NWAVES - 1;
    const int pw = !ded ? F.bid * NWAVES + F.wave : (F.bid < DECB ? F.bid * (NWAVES - 1) + F.wave : DECB * (NWAVES - 1) + (F.bid - DECB) * NWAVES + F.wave);
    const int gt = pw * 64 + F.lane, NGT = (ded ? F.G * NWAVES - DECB : F.G * NWAVES) * 64;
    if (!smp_wave)
    for (int it = gt; it < (MP / 16) * 128; it += NGT) {
        const int run = it >> 7, c8 = it & 127, g = c8 >> 5, w = 2 << g;
        const int r0 = run * 16, t0 = r0 & (SEQ - 1);
        const bf16_t* xg = XG + 8 * c8;
        float s[8];
#pragma unroll
        for (int e = 0; e < 8; ++e) s[e] = 0.f;
        for (int j = 1; j < w; ++j) { if (t0 - j >= 0) { const u32x4 a = *(const u32x4*)(xg + (size_t)(r0 - j) * D); const float rs = __builtin_amdgcn_rsqf(ssq[r0 - j] * (1.f / D) + RMS_EPS);
            s[0] += bflo(a.x) * rs; s[1] += bfhi(a.x) * rs; s[2] += bflo(a.y) * rs; s[3] += bfhi(a.y) * rs; s[4] += bflo(a.z) * rs; s[5] += bfhi(a.z) * rs; s[6] += bflo(a.w) * rs; s[7] += bfhi(a.w) * rs; } }
        const float* sh = mod_l + (size_t)(r0 >> 12) * NMOD + 8 * c8;
#pragma unroll 8
        for (int i = 0; i < 16; ++i) {
            const int r = r0 + i, t = t0 + i;
            const u32x4 a = *(const u32x4*)(xg + (size_t)r * D); const float rs = __builtin_amdgcn_rsqf(ssq[r] * (1.f / D) + RMS_EPS);
            const float a0[8] = {bflo(a.x) * rs, bfhi(a.x) * rs, bflo(a.y) * rs, bfhi(a.y) * rs, bflo(a.z) * rs, bfhi(a.z) * rs, bflo(a.w) * rs, bfhi(a.w) * rs};
#pragma unroll
            for (int e = 0; e < 8; ++e) s[e] += a0[e];
            const int n = (t + 1) < w ? (t + 1) : w;
            const float ic = __builtin_amdgcn_rcpf((float)n);
            u32x4 o; o.x = pk2(s[0] * ic - a0[0], s[1] * ic - a0[1]); o.y = pk2(s[2] * ic - a0[2], s[3] * ic - a0[3]); o.z = pk2(s[4] * ic - a0[4], s[5] * ic - a0[5]); o.w = pk2(s[6] * ic - a0[6], s[7] * ic - a0[7]);
            *(u32x4*)(PB + (size_t)r * D + 8 * c8) = o;
            if (t >= SEQ - POOLST) {
                float* po = F.out + O_POOLP + ((size_t)(r >> 12) * POOLST + (t - (SEQ - POOLST))) * D + 8 * c8;
                *(f32x4*)po = (f32x4){a0[0], a0[1], a0[2], a0[3]} + *(const f32x4*)sh; *(f32x4*)(po + 4) = (f32x4){a0[4], a0[5], a0[6], a0[7]} + *(const f32x4*)(sh + 4); }
            if (t - w + 1 >= 0) {
                const u32x4 q = *(const u32x4*)(xg + (size_t)(r - w + 1) * D); const float rq = __builtin_amdgcn_rsqf(ssq[r - w + 1] * (1.f / D) + RMS_EPS);
                s[0] -= bflo(q.x) * rq; s[1] -= bfhi(q.x) * rq; s[2] -= bflo(q.y) * rq; s[3] -= bfhi(q.y) * rq; s[4] -= bflo(q.z) * rq; s[5] -= bfhi(q.z) * rq; s[6] -= bflo(q.w) * rq; s[7] -= bfhi(q.w) * rq; }
        }
    }
    const int gw = ded ? (smp_wave ? F.bid : DECB) : F.bid * NWAVES + F.wave, NGW = ded ? DECB : F.G * NWAVES;
    for (int seq = gw; seq < DECB; seq += NGW) {
        const float* mr = mod_l + (size_t)(NBATCH + seq) * NMOD;
        f32x4 h[4][4];
#pragma unroll
        for (int t = 0; t < 4; ++t) { float* xr = F.X + (size_t)(MP + seq * DECS + t) * D; float sq = 0.f;
#pragma unroll
            for (int j = 0; j < 4; ++j) { const int c = 4 * F.lane + 256 * j; f32x4 xv = *(const f32x4*)(xr + c);
#pragma unroll
                for (int ks = 0; ks < 8; ++ks) xv += *(const f32x4*)(F.SLAB + ((size_t)ks * MS + seq * DECS + t) * D + c);
                *(f32x4*)(xr + c) = xv; h[t][j] = xv; sq += (h[t][j].x * h[t][j].x + h[t][j].y * h[t][j].y) + (h[t][j].z * h[t][j].z + h[t][j].w * h[t][j].w); }
            const float rstd = __builtin_amdgcn_rsqf(wave_sum(sq) * (1.f / D) + RMS_EPS);
#pragma unroll
            for (int j = 0; j < 4; ++j) { const int c = 4 * F.lane + 256 * j; h[t][j] = h[t][j] * rstd * *(const f32x4*)(F.g_mix + D + c) * (*(const f32x4*)(mr + D + c) + 1.0f) + *(const f32x4*)(mr + c); } }
#pragma unroll
        for (int j = 0; j < 4; ++j) {
            const int c = 4 * F.lane + 256 * j, w = 2 << j;
            f32x4 ext[19];
#pragma unroll
            for (int i = 0; i < POOLST; ++i) ext[i] = *(const f32x4*)(F.state_pool + ((size_t)seq * POOLST + i) * D + c);
#pragma unroll
            for (int t = 0; t < 4; ++t) ext[POOLST + t] = h[t][j];
            const float iw = 1.0f / (float)w;
#pragma unroll
            for (int t = 0; t < 4; ++t) { f32x4 sm = {0.f, 0.f, 0.f, 0.f};
#pragma unroll
                for (int i = 0; i < 16; ++i) if (i < w) sm += ext[POOLST + t - i];
                const f32x4 p = sm * iw - h[t][j]; u32x2 o; o.x = pk2(p[0], p[1]); o.y = pk2(p[2], p[3]);
                *(u32x2*)(PB + (size_t)(MP + seq * DECS + t) * D + c) = o; }
#pragma unroll
            for (int i = 0; i < POOLST; ++i) *(f32x4*)(F.out + O_POOLS + ((size_t)seq * POOLST + i) * D + c) = ext[i + DECS];
        }
    }
}

__device__ __forceinline__ unsigned okey(float f) { const unsigned u = __float_as_uint(f); return (u & 0x80000000u) ? ~u : (u | 0x80000000u); }
__device__ __forceinline__ bf16x8 ld8_bf(const bf16_t* p) { return *(const bf16x8*)p; }
__device__ __forceinline__ bf16x8 ld8_f32(const float* p) { const f32x4 a = *(const f32x4*)p, b = *(const f32x4*)(p + 4); return pack8(a, b); }
__device__ __forceinline__ s16x4 vtr(const LAS unsigned char* p) { typedef short v4i16_t __attribute__((ext_vector_type(4))); return __builtin_bit_cast(s16x4, __builtin_amdgcn_ds_read_tr16_b64_v4i16((LAS v4i16_t*)p)); }

template <bool F32SRC>
__device__ __forceinline__ void attn_query(Frame& F, int lane, const LAS unsigned short* IL, LAS unsigned char* vst, int nsel, int qrow, int b, const int* pt, int seq, int gsel) {
    constexpr int NB = F32SRC ? 2 : 4;
    asm volatile("" : "+v"(lane));
    const int col = lane & 15, kq = lane >> 4;
    bf16x8 Bq[4];
#pragma unroll
    for (int c = 0; c < 4; ++c) { bf16x8 qv = (bf16x8){0, 0, 0, 0, 0, 0, 0, 0}; if (col < 4) qv = ld8_bf(F.QB + (size_t)qrow * D + (gsel * 4 + col) * HD + 32 * c + 8 * kq); Bq[c] = qv; }
    const int lrow = lane >> 2, lpc = lane & 3;
    const int psrc = (4 * col + kq) * 4;
    const char* kbase = (const char*)(F.KB + (size_t)b * SEQ * KVW + gsel * HD) + lpc * 16;
    unsigned koff[16]; const float* kptr[16];
#pragma unroll
    for (int t = 0; t < 16; ++t) {
        if (F32SRC) { const int key = IL[16 * t + col]; kptr[t] = (key < PAST ? F.cache_k + ((size_t)pt[key >> 7] * PAGE + (key & (PAGE - 1))) * KVW : F.out + O_KS + (size_t)(seq * DECS + key - PAST) * KVW) + gsel * HD + 8 * kq; }
        else { const int key = IL[16 * t + lrow]; koff[t] = (unsigned)key * (KVW * 2); } }
    bf16x8 kbuf[NB][4];
#define ATT_LOADU(u) do { _Pragma("unroll") for (int c_ = 0; c_ < 4; ++c_) \
        kbuf[(u) % NB][c_] = F32SRC ? ld8_f32(kptr[u] + 32 * c_) : ld8_bf((const bf16_t*)(kbase + koff[u] + c_ * 64)); } while (0)
#pragma unroll
    for (int u = 0; u < NB; ++u) ATT_LOADU(u);
    f32x4 S[16];
#pragma unroll
    for (int u = 0; u < 16; ++u) {
        f32x4 a = (f32x4){0.f, 0.f, 0.f, 0.f};
#pragma unroll
        for (int c = 0; c < 4; ++c) {
            bf16x8 kf = kbuf[u % NB][c];
            if (!F32SRC) { u32x4 w = __builtin_bit_cast(u32x4, kf);
                w.x = (unsigned)__builtin_amdgcn_ds_bpermute(psrc, (int)w.x); w.y = (unsigned)__builtin_amdgcn_ds_bpermute(psrc, (int)w.y);
                w.z = (unsigned)__builtin_amdgcn_ds_bpermute(psrc, (int)w.z); w.w = (unsigned)__builtin_amdgcn_ds_bpermute(psrc, (int)w.w);
                kf = __builtin_bit_cast(bf16x8, w); }
            a = __builtin_amdgcn_mfma_f32_16x16x32_bf16(kf, Bq[c], a, 0, 0, 0);
        }
        S[u] = a;
        if (u + NB < 16) ATT_LOADU(u + NB);
    }
#undef ATT_LOADU
    u32x4 R[2][4];
    const char* vbase = (const char*)(F.VB + (size_t)b * SEQ * KVW + gsel * HD) + (lane & 15) * 16;
#define ATT_LOADV(hb, blk) do { _Pragma("unroll") for (int ld_ = 0; ld_ < 4; ++ld_) { const int key_ = IL[32 * (blk) + 16 * (hb) + 4 * ld_ + (lane >> 4)]; \
        if (F32SRC) R[hb][ld_] = __builtin_bit_cast(u32x4, ld8_f32((key_ < PAST ? F.cache_v + ((size_t)pt[key_ >> 7] * PAGE + (key_ & (PAGE - 1))) * KVW : F.out + O_VS + (size_t)(seq * DECS + key_ - PAST) * KVW) + gsel * HD + 8 * (lane & 15))); \
        else R[hb][ld_] = *(const u32x4*)(vbase + (unsigned)key_ * (KVW * 2)); } } while (0)
    ATT_LOADV(0, 0); ATT_LOADV(1, 0);
    float mxs = -INFINITY;
    if (nsel < TOPK) {
#pragma unroll
        for (int t = 0; t < 16; ++t)
#pragma unroll
            for (int r = 0; r < 4; ++r) { const int p = 16 * t + 4 * kq + r; if (p >= nsel) S[t][r] = -INFINITY; }
    }
#pragma unroll
    for (int t = 0; t < 16; ++t) mxs = fmaxf(fmaxf(mxs, fmaxf(S[t][0], S[t][1])), fmaxf(S[t][2], S[t][3]));
    mxs = fmaxf(mxs, __shfl_xor(mxs, 16)); mxs = fmaxf(mxs, __shfl_xor(mxs, 32));
    const float c2 = 0.08838834764831845f * 1.4426950408889634f;
    float lsum = 0.f;
#pragma unroll
    for (int t = 0; t < 16; ++t)
#pragma unroll
        for (int r = 0; r < 4; ++r) { const float p = __builtin_amdgcn_exp2f((S[t][r] - mxs) * c2); S[t][r] = p; lsum += p; }
    lsum += __shfl_xor(lsum, 16); lsum += __shfl_xor(lsum, 32);
    bf16x8 PA[8];
#pragma unroll
    for (int i = 0; i < 8; ++i) PA[i] = pack8(S[2 * i], S[2 * i + 1]);
    f32x4 O[8];
#pragma unroll
    for (int dt = 0; dt < 8; ++dt) O[dt] = (f32x4){0.f, 0.f, 0.f, 0.f};
    const int q_ = (lane & 15) >> 2, p_ = lane & 3;
    const int s0 = 4 * kq + q_;
#pragma unroll
    for (int i = 0; i < 8; ++i) {
#pragma unroll
        for (int hb = 0; hb < 2; ++hb) {
#pragma unroll
            for (int ld = 0; ld < 4; ++ld) { const int slot = 16 * hb + 4 * ld + (lane >> 4), ch = lane & 15;
                *(LAS u32x4*)(vst + slot * 256 + ((ch ^ ((slot & 7) << 1)) << 4)) = R[hb][ld]; }
            if (i + 1 < 8) { if (hb == 0) ATT_LOADV(0, i + 1); else ATT_LOADV(1, i + 1); }
        }
        asm volatile("" ::: "memory");
#pragma unroll
        for (int dt = 0; dt < 8; ++dt) {
            const int ch = dt * 2 + (p_ >> 1);
            const LAS unsigned char* a0 = vst + s0 * 256 + ((ch ^ ((s0 & 7) << 1)) << 4) + (p_ & 1) * 8;
            const s16x4 lo = vtr(a0), hi = vtr(a0 + 16 * 256);
            const bf16x8 bv = (bf16x8){lo[0], lo[1], lo[2], lo[3], hi[0], hi[1], hi[2], hi[3]};
            O[dt] = __builtin_amdgcn_mfma_f32_16x16x32_bf16(PA[i], bv, O[dt], 0, 0, 0);
        }
        asm volatile("" ::: "memory");
    }
#undef ATT_LOADV
    float inv[4];
#pragma unroll
    for (int h = 0; h < 4; ++h) inv[h] = __builtin_amdgcn_rcpf(__shfl(lsum, h));
    if (kq == 0) {
        bf16_t* ob = F.OB + (size_t)qrow * D + gsel * 4 * HD;
#pragma unroll
        for (int dt = 0; dt < 8; ++dt)
#pragma unroll
            for (int r = 0; r < 4; ++r) ob[r * HD + 16 * dt + col] = (bf16_t)(pk2(O[dt][r] * inv[r], 0.f) & 0xffffu);
    }
}

template <bool SAMPLE>
__device__ __forceinline__ void dsa_item(Frame& F, int item) {
    constexpr int NQ = SAMPLE ? 4 : 8, NG = SAMPLE ? 1 : 2, NREG = SAMPLE ? 33 : 64;
    int lane = F.lane; asm volatile("" : "+v"(lane));
    const int w = F.wave;
    LAS float* SC = (LAS float*)F.lds;
    LAS unsigned short* IDXL = (LAS unsigned short*)(F.lds + IDXL_OFF);
    const int seq = item;
    const int b = SAMPLE ? seq : (item & 3), t0 = SAMPLE ? PAST : (item >> 2) * 8;
    const int row0 = SAMPLE ? MP + seq * DECS : b * SEQ + t0;
    const int* pt = F.page_table + (SAMPLE ? seq * PAGES_PER_SEQ : 0);
    {
        const int r = lane & 31, hk = lane >> 5, hi = hk;
        const int q4 = (r >> 4) + 2 * ((r >> 2) & 1), head = (r & 3) + 4 * ((r >> 3) & 1);
        bf16x8 afr[NG][4]; float wiA[NG][8], wiB[NG][8];
        const float cs = 0.125f * 0.35355339059327373f;
#pragma unroll
        for (int G = 0; G < NG; ++G) {
#pragma unroll
            for (int c = 0; c < 4; ++c) afr[G][c] = ld8_bf(F.QIB + (size_t)(row0 + 4 * G + q4) * QIW + head * IDD + 16 * c + 8 * hk);
            const float* wa = F.WIF + (size_t)(row0 + 4 * G + 2 * hi) * 8;
#pragma unroll
            for (int h = 0; h < 8; ++h) { wiA[G][h] = wa[h] * cs; wiB[G][h] = wa[8 + h] * cs; }
        }
        const int nkt = SAMPLE ? 65 : (t0 + 8 + 31) / 32;
        auto load_tile = [&](bf16x8 (&fr)[4], int kt) {
            if (SAMPLE) {
                const int s_ = 32 * kt + r, sc = s_ < PAST + DECS - 1 ? s_ : PAST + DECS - 1;
                const int page = pt[kt < PAST / 32 ? (kt >> 2) : 0];
                const float* kp = kt < PAST / 32 ? F.cache_ki + ((size_t)page * PAGE + (sc & (PAGE - 1))) * IDD : F.out + O_KIS + (size_t)(seq * DECS + sc - PAST) * IDD;
#pragma unroll
                for (int c = 0; c < 4; ++c) fr[c] = ld8_f32(kp + 16 * c + 8 * hk);
            } else {
                const bf16_t* kp = F.KIB + ((size_t)(b * SEQ) / 32 + kt) * (32 * IDD) + (hk * 32 + r) * 8;
#pragma unroll
                for (int c = 0; c < 4; ++c) fr[c] = ld8_bf(kp + c * (2 * 32 * 8));
            }
        };
        auto do_tile = [&](const bf16x8 (&fr)[4], int kt) {
            const int s_ = 32 * kt + r;
#pragma unroll
            for (int G = 0; G < NG; ++G) {
                f32x16 acc;
#pragma unroll
                for (int i = 0; i < 16; ++i) acc[i] = 0.f;
#pragma unroll
                for (int c = 0; c < 4; ++c) acc = __builtin_amdgcn_mfma_f32_32x32x16_bf16(afr[G][c], fr[c], acc, 0, 0, 0);
                float sA = 0.f, sB = 0.f;
#pragma unroll
                for (int h = 0; h < 8; ++h) { sA += __builtin_amdgcn_fmed3f(acc[h], 0.f, __builtin_inff()) * wiA[G][h]; sB += __builtin_amdgcn_fmed3f(acc[8 + h], 0.f, __builtin_inff()) * wiB[G][h]; }
                SC[(4 * G + 2 * hi) * 4096 + s_] = sA + 0.0f; SC[(4 * G + 2 * hi + 1) * 4096 + s_] = sB + 0.0f;
            }
        };
        bf16x8 f0[4], f1[4], f2[4];
        int kt = w;
        if (kt < nkt) load_tile(f0, kt);
        if (kt + NWAVES < nkt) load_tile(f1, kt + NWAVES);
        for (; kt < nkt; kt += 3 * NWAVES) {
            if (kt + 2 * NWAVES < nkt) load_tile(f2, kt + 2 * NWAVES);
            do_tile(f0, kt);
            if (kt + NWAVES < nkt) { if (kt + 3 * NWAVES < nkt) load_tile(f0, kt + 3 * NWAVES); do_tile(f1, kt + NWAVES); }
            if (kt + 2 * NWAVES < nkt) { if (kt + 4 * NWAVES < nkt) load_tile(f1, kt + 4 * NWAVES); do_tile(f2, kt + 2 * NWAVES); }
        }
    }
    __syncthreads();
    if (w < NQ) {
        asm volatile("" : "+v"(lane));
        const int qi = w;
        const int pos = t0 + qi, nvalid = pos + 1;
        const int nsel = nvalid < TOPK ? nvalid : TOPK;
        LAS unsigned short* IL = IDXL + w * 256;
        if (nvalid <= TOPK) {
#pragma unroll
            for (int i = 0; i < 4; ++i) { const int p = lane + 64 * i; IL[p] = (unsigned short)(p < nvalid ? p : 0); }
        } else {
            const LAS float* scl = SC + qi * 4096 + lane; asm volatile("" : "+v"(scl));
            constexpr int NCH = (NREG + 7) / 8;
            const int nch = (nvalid + 511) >> 9;
            unsigned u[NCH * 8]; unsigned mx = 0u;
#pragma unroll
            for (int c = 0; c < NCH; ++c) {
#pragma unroll
                for (int j = 0; j < 8; ++j) u[8 * c + j] = 0u;
                if (c < nch) {
#pragma unroll
                    for (int j = 0; j < 8; ++j) { const int s = 64 * (8 * c + j) + lane; const unsigned k = okey(scl[64 * (8 * c + j)]); u[8 * c + j] = s < nvalid ? k : 0u; mx = mx > u[8 * c + j] ? mx : u[8 * c + j]; }
                }
            }
            mx = wave_max_u(mx);
            LAS unsigned* hist = (LAS unsigned*)(F.lds + HIST_OFF) + w * 256;
            unsigned lo, wl, above = 0u, T, ngt;
            if (mx >= 0x80000000u + (1u << 25)) { lo = mx + 1u - (1u << 25); wl = 25u; } else { lo = 0u; wl = 32u; }
            for (;;) {
                const unsigned shift = wl > 8u ? wl - 8u : 0u;
                *(LAS u32x4*)(hist + 4 * lane) = (u32x4){0u, 0u, 0u, 0u};
#pragma unroll
                for (int c = 0; c < NCH; ++c) {
                    if (c < nch) {
#pragma unroll
                        for (int j = 0; j < 8; ++j) { const unsigned d = u[8 * c + j] - lo; const bool in = wl >= 32u ? true : (d >> wl) == 0u;
                            if (in) (void)__hip_atomic_fetch_add(hist + (d >> shift), 1u, __ATOMIC_RELAXED, __HIP_MEMORY_SCOPE_WORKGROUP); }
                    }
                }
                LDS_WAIT(); asm volatile("" ::: "memory");
                const u32x4 h4 = *(const LAS u32x4*)(hist + 4 * lane);
                const unsigned sl = (h4.x + h4.y) + (h4.z + h4.w);
                unsigned pre = sl;
#pragma unroll
                for (int o = 1; o < 64; o <<= 1) { const unsigned t = (unsigned)__shfl_up((int)pre, o); if (lane >= o) pre += t; }
                const unsigned total = (unsigned)__builtin_amdgcn_readlane((int)pre, 63);
                if (above + total < (unsigned)TOPK) { lo = 0u; wl = 32u; above = 0u; continue; }
                const unsigned suf = total - pre + sl;
                const unsigned long long bm = __ballot(above + suf >= (unsigned)TOPK);
                const int L = 63 - __builtin_clzll(bm);
                unsigned acc = above + suf - sl, bsel = 0u, csel = 0u, asel = 0u; bool fnd = false;
#pragma unroll
                for (int q = 3; q >= 0; --q) { const unsigned h = h4[q]; if (!fnd && acc + h >= (unsigned)TOPK) { bsel = 4u * (unsigned)lane + (unsigned)q; csel = h; asel = acc; fnd = true; } acc += h; }
                const unsigned bstar = (unsigned)__builtin_amdgcn_readlane((int)bsel, L), cnt_b = (unsigned)__builtin_amdgcn_readlane((int)csel, L);
                above = (unsigned)__builtin_amdgcn_readlane((int)asel, L);
                lo += bstar << shift;
                if (above + cnt_b == (unsigned)TOPK) { T = lo - 1u; ngt = (unsigned)TOPK; break; }
                if (shift == 0u) { T = lo; ngt = above; break; }
                wl = shift;
            }
            const unsigned need_eq = (unsigned)TOPK - ngt;
            unsigned base = 0u, eqb = 0u;
#pragma unroll
            for (int c = 0; c < NCH; ++c) {
                if (c < nch) {
#pragma unroll
                    for (int j = 0; j < 8; ++j) {
                        const int i = 8 * c + j;
                        const bool gt = u[i] > T, eq = u[i] == T;
                        const unsigned long long be = __ballot(eq);
                        const unsigned er = eqb + __builtin_amdgcn_mbcnt_hi((unsigned)(be >> 32), __builtin_amdgcn_mbcnt_lo((unsigned)be, 0u));
                        const bool sel = gt || (eq && er < need_eq);
                        const unsigned long long bs = __ballot(sel);
                        const unsigned p = base + __builtin_amdgcn_mbcnt_hi((unsigned)(bs >> 32), __builtin_amdgcn_mbcnt_lo((unsigned)bs, 0u));
                        if (sel && p < (unsigned)TOPK) IL[p] = (unsigned short)(64 * i + lane);
                        base += (unsigned)__popcll(bs); eqb += (unsigned)__popcll(be);
                    }
                }
            }
        }
        LDS_WAIT(); asm volatile("" ::: "memory");
        *(u32x2*)(F.ILG + (size_t)(row0 + qi) * TOPK + 4 * lane) = *(const LAS u32x2*)(IL + 4 * lane);
    }
    __syncthreads();
}
__device__ __forceinline__ void dsa_select_phase(Frame& F) {
    for (int k = F.bid; k < MP / 8; k += F.G) { const int kk = ((k >> 8) & 1) ? (k ^ 255) : k; dsa_item<false>(F, kk); }
    for (int s = F.bid; s < DECB; s += F.G) dsa_item<true>(F, s);
}
__device__ __forceinline__ void dsa_attn_phase(Frame& F, unsigned* bar, volatile LAS unsigned* st) {
    int lane = F.lane; asm volatile("" : "+v"(lane));
    const int w = F.wave;
    LAS unsigned short* IL = (LAS unsigned short*)(F.lds + IDXL_OFF) + w * 256;
    LAS unsigned char* vst = F.lds + w * 8192;
    if (F.tid == 0) {
        unsigned ok = 1u, nx = 0u, vx = 0u; const unsigned x = st[3];
        for (unsigned j = 0; j < 16; ++j) { const unsigned c = xb_ld(&bar[XB_XCNT(j)]); if (c) { if (c != 32u) ok = 0u; if (j < x) ++vx; ++nx; } }
        if (nx != 8u || F.G != 256) ok = 0u;
        st[4] = ok; st[5] = vx;
    }
    __syncthreads();
    const bool xok = st[4] != 0u;
    const int vx = xok ? (int)st[5] : (F.bid & 7), rk = xok ? (int)st[2] : (F.bid >> 3);
    if (F.G == 256) {
        const int b = vx >> 1, g = vx & 1, wv = rk * 8 + w;
        const int ntask = w < 4 ? 15 : 17;
        for (int i = 0; i < ntask; ++i) {
            const int t = i < 15 ? wv + 256 * i : (i == 15 ? 3840 + rk * 8 + 2 * (w - 4) : 3840 + rk * 8 + 2 * (w - 4) + 1), qrow = b * SEQ + t;
            *(LAS u32x2*)(IL + 4 * lane) = *(const u32x2*)(F.ILG + (size_t)qrow * TOPK + 4 * lane);
            attn_query<false>(F, lane, IL, vst, t + 1 < TOPK ? t + 1 : TOPK, qrow, b, nullptr, 0, g);
        }
    } else {
        for (int task = F.bid * NWAVES + w; task < MP * 2; task += F.G * NWAVES) {
            const int qrow = task >> 1, g = task & 1, b = qrow >> 12, t = qrow & (SEQ - 1);
            *(LAS u32x2*)(IL + 4 * lane) = *(const u32x2*)(F.ILG + (size_t)qrow * TOPK + 4 * lane);
            attn_query<false>(F, lane, IL, vst, t + 1 < TOPK ? t + 1 : TOPK, qrow, b, nullptr, 0, g);
        }
    }
    if (w < 4) {
        for (int task = F.bid * 4 + w; task < MS * 2; task += F.G * 4) {
            const int q = task >> 1, g = task & 1, seq = q >> 2, qrow = MP + q;
            *(LAS u32x2*)(IL + 4 * lane) = *(const u32x2*)(F.ILG + (size_t)qrow * TOPK + 4 * lane);
            attn_query<true>(F, lane, IL, vst, TOPK, qrow, 0, F.page_table + seq * PAGES_PER_SEQ, seq, g);
        }
    }
}

__global__ void __launch_bounds__(NTHREADS, 2) fwd_megakernel(Params P) {
    extern __shared__ __attribute__((aligned(16))) unsigned char lds_raw[];
    Frame F;
#define BUILD_FRAME() do { \
    int tid_ = threadIdx.x; asm volatile("" : "+v"(tid_)); \
    unsigned char* ws_ = as_global(P.ws); float* out_ = as_global(P.out); \
    F.lds = (LAS unsigned char*)lds_raw; \
    F.tid = tid_; F.lane = F.tid & 63; F.wave = __builtin_amdgcn_readfirstlane(F.tid >> 6); F.G = gridDim.x; F.bid = blockIdx.x; \
    F.x_p = as_global(P.in[0]); F.x_s = as_global(P.in[1]); F.cache_k = as_global(P.in[2]); F.cache_v = as_global(P.in[3]); F.cache_ki = as_global(P.in[4]); F.state_pool = as_global(P.in[5]); F.page_table = as_global((const int*)P.in[6]); \
    F.c_p = as_global(P.in[7]); F.c_s = as_global(P.in[8]); F.g_mix = as_global(P.in[9]); F.g_ffn = as_global(P.in[10]); F.w_mod = as_global(P.in[11]); F.b_mod = as_global(P.in[12]); F.w_in = as_global(P.in[13]); F.w_o = as_global(P.in[14]); \
    F.pool_w = as_global(P.in[15]); F.pool_scale = as_global(P.in[16]); F.w_up = as_global(P.in[17]); F.w_down = as_global(P.in[18]); F.g_final = as_global(P.in[19]); \
    F.out = out_; F.ws = ws_; \
    F.MOD = (float*)(ws_ + WS_MOD); F.SILU = (bf16_t*)(ws_ + WS_SILU); F.WIN = (bf16_t*)(ws_ + WS_WIN); F.WO = (bf16_t*)(ws_ + WS_WO); F.WPOOL = (bf16_t*)(ws_ + WS_WPOOL); \
    F.WUP = (bf16_t*)(ws_ + WS_WUP); F.WDN = (bf16_t*)(ws_ + WS_WDN); F.HB = (bf16_t*)(ws_ + WS_HB); F.QB = (bf16_t*)(ws_ + WS_QB); F.KB = (bf16_t*)(ws_ + WS_KB); F.VB = (bf16_t*)(ws_ + WS_VB); \
    F.QIB = (bf16_t*)(ws_ + WS_QIB); F.KIB = (bf16_t*)(ws_ + WS_KIB); F.WIF = (float*)(ws_ + WS_WIF); F.OB = (bf16_t*)(ws_ + WS_OB); F.X = (float*)(ws_ + WS_X); F.UB = (bf16_t*)(ws_ + WS_UB); F.ILG = (unsigned short*)(ws_ + WS_IL); F.GS = (float*)(ws_ + WS_GS); F.BIAS = (float*)(ws_ + WS_BIAS); F.SHB = (bf16_t*)(ws_ + WS_SHB); F.SLAB = (float*)(ws_ + WS_SLAB); F.SSQ = (float*)(ws_ + WS_CTL) + CW_SSQ; \
    mod0 = F.MOD; mod1 = F.MOD + (size_t)NBROW * NMOD; } while (0)
    const float* mod0; const float* mod1;
    unsigned char* ws = P.ws;
    volatile LAS unsigned* MISC = (volatile LAS unsigned*)((LAS unsigned char*)lds_raw + MISC_OFF);
    for (int u = threadIdx.x; u < 64; u += NTHREADS) MISC[u] = 0u;
    __syncthreads();
    XcdBarrier bar = xcd_barrier_post((unsigned*)(ws + WS_CTL) + CW_BAR, MISC + 8);
#define GRID_BAR() do { xcd_barrier(bar); BUILD_FRAME(); } while (0)

    BUILD_FRAME();
    p0(F);
    GRID_BAR();
    rowpass_first(F, mod0);
    GRID_BAR();
    {   pg8::Gemm g{F.HB, F.WIN, MT, NPROJ, D, D, D, 0}; pg8::MixOrder S; S.init(MP, MS, NPROJ, D, 1, F.G, F.bid);
        EpiProj E{F.QB, F.KB, F.VB, F.QIB, F.KIB, F.WIF, F.out};
        pg8::gemm_phase<EpiProj, pg8::MixOrder, true>(F.lds, g, S, E); }
    {   pg8::Gemm g{F.SHB, F.WUP, 512, 2 * DFF, D, D, D, 0}; BiasOrder S{F.bid};
        EpiBias E{F.BIAS};
        pg8::gemm_phase<EpiBias, BiasOrder, true>(F.lds, g, S, E); }
    GRID_BAR();
    dsa_select_phase(F);
    GRID_BAR();
    dsa_attn_phase(F, (unsigned*)(ws + WS_CTL) + CW_BAR, MISC + 8);
    GRID_BAR();
    {   pg8::Gemm g{F.OB, F.WO, MT, D, D, D, D, 0}; pg8::MixOrder S; S.init(MP, MS, D, D, 8, F.G, F.bid);
        EpiRes<1, false> E{F.x_p, F.x_s, F.X, mod0 + 2 * D, nullptr, F.GS, F.HB, F.SSQ, false, F.SLAB};
        pg8::gemm_phase<EpiRes<1, false>, pg8::MixOrder, true>(F.lds, g, S, E); }
    GRID_BAR();
    samplefix(F, F.x_s, 8, F.g_ffn, mod0);
    GRID_BAR();
    {   pg8::Gemm g{F.HB, F.WUP, MT, DFF, D, D, D, 0}; pg8::MixOrder S; S.init(MP, MS, DFF, D, 1, F.G, F.bid);
        EpiUp E{F.UB, F.SSQ, F.BIAS};
        pg8::gemm_phase<EpiUp, pg8::MixOrder, true>(F.lds, g, S, E); }
    GRID_BAR();
    {   pg8::Gemm g{F.UB, F.WDN, MT, D, DFF, DFF, DFF, 0}; pg8::MixOrder S; S.init(MP, MS, D, DFF, 8, F.G, F.bid);
        EpiRes<1, true> E{F.X, F.X + (size_t)MP * D, F.X, mod0 + 5 * D, nullptr, F.GS + (size_t)NBROW * D, F.HB, F.SSQ + MT, true, F.SLAB};
        pg8::gemm_phase<EpiRes<1, true>, pg8::MixOrder, true>(F.lds, g, S, E); }
    GRID_BAR();
    poolpass(F, F.HB, F.SSQ + MT, mod1, F.OB);
    GRID_BAR();
    {   pg8::Gemm g{F.OB, F.WPOOL, MT, D, 256, D, 256, 256}; pg8::MixOrder S; S.init(MP, MS, D, 256, 2, F.G, F.bid);
        EpiRes<1, true> E{F.X, F.X + (size_t)MP * D, F.X, mod1 + 2 * D, F.pool_scale, F.GS + (size_t)2 * NBROW * D, F.HB, F.SSQ + 2 * MT, true, F.SLAB};
        pg8::gemm_phase<EpiRes<1, true>, pg8::MixOrder, true>(F.lds, g, S, E); }
    GRID_BAR();
    samplefix(F, F.X + (size_t)MP * D, 2, F.g_ffn + D, mod1);
    GRID_BAR();
    {   pg8::Gemm g{F.HB, F.WUP + (size_t)D * DFF, MT, DFF, D, D, D, 0}; pg8::MixOrder S; S.init(MP, MS, DFF, D, 1, F.G, F.bid);
        EpiUp E{F.UB, F.SSQ + 2 * MT, F.BIAS + (size_t)256 * DFF};
        pg8::gemm_phase<EpiUp, pg8::MixOrder, true>(F.lds, g, S, E); }
    GRID_BAR();
    {   pg8::Gemm g{F.UB, F.WDN + (size_t)D * DFF, MT, D, DFF, DFF, DFF, 0}; pg8::MixOrder S; S.init(MP, MS, D, DFF, 8, F.G, F.bid);
        EpiRes<2, true> E{F.X, F.X + (size_t)MP * D, F.X, mod1 + 5 * D, nullptr, nullptr, nullptr, F.SSQ + 3 * MT, true, F.SLAB};
        pg8::gemm_phase<EpiRes<2, true>, pg8::MixOrder, true>(F.lds, g, S, E); }
    GRID_BAR();
    finalpass(F);
}

extern "C" void kernel_launch(void* const* d_in, const int* in_sizes, int n_in, void* d_out, int out_size, void* d_ws, size_t ws_size, hipStream_t stream) {
    static int grid = 0;
    if (grid == 0) {
        if (n_in != 20 || (size_t)out_size != O_END || ws_size < WS_END) { fprintf(stderr, "kernel_launch: unexpected shapes (n_in %d out %d ws %zu)\n", n_in, out_size, ws_size); grid = -1; return; }
        int dev = 0, cus = 0, per_cu = 0;
        if (hipGetDevice(&dev) != hipSuccess || hipDeviceGetAttribute(&cus, hipDeviceAttributeMultiprocessorCount, dev) != hipSuccess) { grid = -1; return; }
        if (hipFuncSetAttribute((const void*)fwd_megakernel, hipFuncAttributeMaxDynamicSharedMemorySize, LDS_BYTES) != hipSuccess) { fprintf(stderr, "kernel_launch: hipFuncSetAttribute failed\n"); grid = -1; return; }
        if (hipOccupancyMaxActiveBlocksPerMultiprocessor(&per_cu, (const void*)fwd_megakernel, NTHREADS, LDS_BYTES) != hipSuccess || per_cu < 1) { fprintf(stderr, "kernel_launch: occupancy query failed (%d)\n", per_cu); (void)hipGetLastError(); grid = -1; return; }
        grid = cus;
    }
    if (grid < 0) return;
    (void)hipMemsetAsync((char*)d_ws + WS_CTL, 0, CTL_ZERO_BYTES, stream);
    Params p{};
    for (int i = 0; i < 20; ++i) p.in[i] = (const float*)d_in[i];
    p.out = (float*)d_out; p.ws = (unsigned char*)d_ws;
    void* args[] = {&p};
    hipError_t e = hipLaunchCooperativeKernel((const void*)fwd_megakernel, dim3(grid), dim3(NTHREADS), args, LDS_BYTES, stream);
    if (e != hipSuccess) fprintf(stderr, "cooperative launch failed: %s (grid %d)\n", hipGetErrorString(e), grid);
}
```
